# Optimizing an MI355X kernel written in HIP

```python
import math
import jax, jax.numpy as jnp
from jax import lax
import numpy as np

D_MODEL = 1024
BATCH = 32
SEQ = 256
DEPTH = 1
DEC_BATCH = 4
DEC_SEQ = 1024
PAST_LEN = 256

GRID_W = 64
N_HEADS_ATTN = 8
HEAD_DIM = 64
ATTN_WIDTH = N_HEADS_ATTN * HEAD_DIM
HY_CH = D_MODEL - ATTN_WIDTH
MIX_WIDTH = ATTN_WIDTH + HY_CH
IN_COLS = 3 * ATTN_WIDTH + 3 * HY_CH
WIN_ROWS = 8
WIN_COLS = 16
D_FF = 2816
HY_ORDER = 2
FILT_FREQS = 8
FILT_EMB = 2 * FILT_FREQS + 1
FILT_HID = 64
DECAY_TARGET = 1e-2
FAST_DECAY_PCT = 0.3
SLOW_DECAY_PCT = 1.5
MAX_DECAY = math.log(DECAY_TARGET) / FAST_DECAY_PCT
MIN_DECAY = math.log(DECAY_TARGET) / SLOW_DECAY_PCT
Q_BLOCK = 128
EPS = 1e-6
NEG = -1e30

kernel_name = "hymba_natten_hyena_prefix_dit_step"


def _rmsnorm(x, g):
    xf = x.astype(jnp.float32)
    y = xf * lax.rsqrt(jnp.mean(xf * xf, axis=-1, keepdims=True) + EPS)
    return (y * g.astype(jnp.float32)).astype(x.dtype)


def _adaln(cvec, w_ada, b_ada):
    m = jax.nn.silu(cvec) @ w_ada + b_ada
    return [t[:, None, :] for t in jnp.split(m, 6, axis=-1)]


def _dwconv3(x, w, b):
    xp = jnp.pad(x, ((0, 0), (1, 1), (0, 0)))
    return xp[:, :-2] * w[0] + xp[:, 1:-1] * w[1] + xp[:, 2:] * w[2] + b


def _filter_spectrum(L, w1, b1, w2, b2, w3, b3, freq):
    t = jnp.arange(L, dtype=jnp.float32) / L
    f = jnp.arange(1, FILT_FREQS + 1, dtype=jnp.float32)
    ang = 2.0 * math.pi * t[:, None] * f[None, :]
    z = jnp.concatenate([t[:, None], jnp.cos(ang), jnp.sin(ang)], axis=-1)
    h = jnp.sin(freq * (z @ w1 + b1))
    h = jnp.sin(freq * (h @ w2 + b2))
    h = (h @ w3 + b3).astype(jnp.float32).reshape(L, HY_ORDER, 2, HY_CH)
    deltas = jnp.abs(jnp.linspace(MIN_DECAY, MAX_DECAY, HY_CH, dtype=jnp.float32))
    decay = jnp.exp(-t[:, None] * deltas[None, :])
    h = h * decay[:, None, None, :]
    fwd, bwd = h[:, :, 0], h[:, :, 1]
    k_full = jnp.concatenate([fwd, jnp.zeros((1, HY_ORDER, HY_CH), jnp.float32),
                              jnp.flip(bwd[1:], axis=0)], axis=0)
    return jnp.fft.rfft(k_full, axis=0)


def _long_conv(u, k_f, bias):
    L = u.shape[1]
    uf = u.astype(jnp.float32)
    y = jnp.fft.irfft(jnp.fft.rfft(uf, n=2 * L, axis=1) * k_f[None], n=2 * L, axis=1)[:, :L]
    return (y + uf * bias.astype(jnp.float32)).astype(u.dtype)


def _hyena(hy, k_f, filt_bias):
    x1, x2, v = jnp.split(hy, 3, axis=-1)
    z = x1 * _long_conv(v, k_f[:, 0], filt_bias[0])
    return x2 * _long_conv(z, k_f[:, 1], filt_bias[1])


def _ctx_attention(q, k, v):
    B, H, L, dh = q.shape
    nb = L // Q_BLOCK
    qb = q.reshape(B, H, nb, Q_BLOCK, dh).transpose(2, 0, 1, 3, 4)
    scale = HEAD_DIM ** -0.5

    def blk(qi):
        s = jnp.einsum('bhqd,bhkd->bhqk', qi, k).astype(jnp.float32) * scale
        p = jax.nn.softmax(s, axis=-1).astype(v.dtype)
        return jnp.einsum('bhqk,bhkd->bhqd', p, v)

    o = lax.map(blk, qb)
    return o.transpose(1, 2, 0, 3, 4).reshape(B, H, L, dh)


def _neighbourhood_attention(q, k, v, k_ctx, v_ctx, rpb):
    B, H, N, dh = q.shape
    R = N // GRID_W
    W = GRID_W
    wr = min(WIN_ROWS, R)
    scale = HEAD_DIM ** -0.5
    qg = q.reshape(B, H, R, W, dh)
    kg = k.reshape(B, H, R, W, dh)
    vg = v.reshape(B, H, R, W, dh)
    r = jnp.arange(R)
    row_start = jnp.clip(r - wr // 2, 0, R - wr)
    row_idx = row_start[:, None] + jnp.arange(wr)[None, :]
    k_band = kg[:, :, row_idx]
    v_band = vg[:, :, row_idx]
    col = jnp.arange(W)
    col_start = jnp.clip(col - WIN_COLS // 2, 0, W - WIN_COLS)
    col_in = (col[None, :] >= col_start[:, None]) & (col[None, :] < col_start[:, None] + WIN_COLS)
    dr = row_idx - r[:, None] + (WIN_ROWS - 1)
    dc = jnp.clip(col[None, :] - col[:, None], -(WIN_COLS - 1), WIN_COLS - 1) + (WIN_COLS - 1)
    bias = rpb[:, dr[:, None, :, None], dc[None, :, None, :]].astype(jnp.float32)
    s_loc = jnp.einsum('bhrqd,bhrikd->bhrqik', qg, k_band).astype(jnp.float32) * scale
    s_loc = jnp.where(col_in[None, None, None, :, None, :], s_loc + bias[None], NEG)
    s_loc = s_loc.reshape(B, H, R, W, wr * W)
    s_ctx = jnp.einsum('bhrqd,bhkd->bhrqk', qg, k_ctx).astype(jnp.float32) * scale
    p = jax.nn.softmax(jnp.concatenate([s_loc, s_ctx], axis=-1), axis=-1).astype(v.dtype)
    p_loc = p[..., :wr * W].reshape(B, H, R, W, wr, W)
    p_ctx = p[..., wr * W:]
    o = (jnp.einsum('bhrqik,bhrikd->bhrqd', p_loc, v_band)
         + jnp.einsum('bhrqk,bhkd->bhrqd', p_ctx, v_ctx))
    return o.reshape(B, H, N, dh)


def _heads(t):
    B, L, _ = t.shape
    return t.reshape(B, L, N_HEADS_ATTN, HEAD_DIM).transpose(0, 2, 1, 3)


def _layer(x, mods, attend, norm1_g, w_in, hy_conv_w, hy_conv_b, k_f, filt_bias,
           grp_norm_g, w_out, norm2_g, w_up, ffn_conv_w, ffn_conv_b, w_down):
    sh1, sc1, g1, sh2, sc2, g2 = mods
    B, L, _ = x.shape
    h = _rmsnorm(x, norm1_g) * (1.0 + sc1) + sh1
    proj = h @ w_in
    q = _heads(proj[..., :ATTN_WIDTH])
    k = _heads(proj[..., ATTN_WIDTH:2 * ATTN_WIDTH])
    v = _heads(proj[..., 2 * ATTN_WIDTH:3 * ATTN_WIDTH])
    hy = _dwconv3(proj[..., 3 * ATTN_WIDTH:], hy_conv_w, hy_conv_b)
    a = attend(q, k, v).transpose(0, 2, 1, 3).reshape(B, L, ATTN_WIDTH)
    hyo = _hyena(hy, k_f, filt_bias)
    merged = jnp.concatenate([_rmsnorm(a, grp_norm_g[:ATTN_WIDTH]),
                              _rmsnorm(hyo, grp_norm_g[ATTN_WIDTH:])], axis=-1)
    x = x + g1 * (merged @ w_out)
    h2 = _rmsnorm(x, norm2_g) * (1.0 + sc2) + sh2
    u = _dwconv3(h2 @ w_up, ffn_conv_w, ffn_conv_b)
    gate, up = jnp.split(u, 2, axis=-1)
    x = x + g2 * ((jax.nn.silu(gate) * up) @ w_down)
    return x, k, v


def setup_inputs(seed: int = 0) -> dict:
    key = jax.random.key(seed)
    ks = jax.random.split(key, 32)
    n = jax.random.normal
    f32 = jnp.float32
    D = D_MODEL
    return {
        "x_prompt": n(ks[0], (BATCH, SEQ, D), f32),
        "x_sample": n(ks[1], (DEC_BATCH, DEC_SEQ, D), f32),
        "cache_ctx_k": n(ks[2], (DEC_BATCH, DEPTH, N_HEADS_ATTN, PAST_LEN, HEAD_DIM), f32),
        "cache_ctx_v": n(ks[3], (DEC_BATCH, DEPTH, N_HEADS_ATTN, PAST_LEN, HEAD_DIM), f32),
        "c": n(ks[4], (DEC_BATCH, D), f32),
        "c_ctx": n(ks[5], (D,), f32),
        "w_ada": n(ks[6], (DEPTH, D, 6 * D), f32) * (0.5 * D ** -0.5),
        "b_ada": n(ks[7], (DEPTH, 6 * D), f32) * 0.02,
        "norm1_g": 1.0 + 0.05 * n(ks[8], (DEPTH, D), f32),
        "w_in": n(ks[9], (DEPTH, D, IN_COLS), f32) * D ** -0.5,
        "rpb": n(ks[10], (DEPTH, N_HEADS_ATTN, 2 * WIN_ROWS - 1, 2 * WIN_COLS - 1), f32) * 0.1,
        "hy_conv_w": n(ks[11], (DEPTH, 3, 3 * HY_CH), f32) * (3.0 ** -0.5),
        "hy_conv_b": n(ks[12], (DEPTH, 3 * HY_CH), f32) * 0.02,
        "filt_w1": n(ks[13], (DEPTH, FILT_EMB, FILT_HID), f32) * FILT_EMB ** -0.5,
        "filt_b1": n(ks[14], (DEPTH, FILT_HID), f32) * 0.1,
        "filt_w2": n(ks[15], (DEPTH, FILT_HID, FILT_HID), f32) * FILT_HID ** -0.5,
        "filt_b2": n(ks[16], (DEPTH, FILT_HID), f32) * 0.1,
        "filt_w3": n(ks[17], (DEPTH, FILT_HID, HY_ORDER * 2 * HY_CH), f32) * (0.05 * FILT_HID ** -0.5),
        "filt_b3": n(ks[18], (DEPTH, HY_ORDER * 2 * HY_CH), f32) * 0.01,
        "filt_freq": 1.0 + 0.1 * n(ks[19], (DEPTH, FILT_HID), f32),
        "filt_bias": n(ks[20], (DEPTH, HY_ORDER, HY_CH), f32) * 0.1,
        "grp_norm_g": 1.0 + 0.05 * n(ks[21], (DEPTH, MIX_WIDTH), f32),
        "w_out": n(ks[22], (DEPTH, MIX_WIDTH, D), f32) * MIX_WIDTH ** -0.5,
        "norm2_g": 1.0 + 0.05 * n(ks[23], (DEPTH, D), f32),
        "w_up": n(ks[24], (DEPTH, D, 2 * D_FF), f32) * D ** -0.5,
        "ffn_conv_w": n(ks[25], (DEPTH, 3, 2 * D_FF), f32) * (3.0 ** -0.5),
        "ffn_conv_b": n(ks[26], (DEPTH, 2 * D_FF), f32) * 0.02,
        "w_down": n(ks[27], (DEPTH, D_FF, D), f32) * D_FF ** -0.5,
        "final_g": 1.0 + 0.05 * n(ks[28], (D,), f32),
    }


def reference(x_prompt, x_sample, cache_ctx_k, cache_ctx_v, c, c_ctx, w_ada, b_ada, norm1_g,
              w_in, rpb, hy_conv_w, hy_conv_b, filt_w1, filt_b1, filt_w2, filt_b2, filt_w3,
              filt_b3, filt_freq, filt_bias, grp_norm_g, w_out, norm2_g, w_up, ffn_conv_w,
              ffn_conv_b, w_down, final_g):
    xc = x_prompt
    xs = x_sample
    L_ctx = xc.shape[1]
    L_lat = xs.shape[1]
    ks_out, vs_out = [], []
    for l in range(DEPTH):
        shared = (norm1_g[l], w_in[l], hy_conv_w[l], hy_conv_b[l])
        tail = (grp_norm_g[l], w_out[l], norm2_g[l], w_up[l], ffn_conv_w[l], ffn_conv_b[l], w_down[l])
        filt = (filt_w1[l], filt_b1[l], filt_w2[l], filt_b2[l], filt_w3[l], filt_b3[l], filt_freq[l])
        mods_ctx = _adaln(c_ctx[None, :], w_ada[l], b_ada[l])
        kf_ctx = _filter_spectrum(L_ctx, *filt)
        xc, k_c, v_c = _layer(xc, mods_ctx, _ctx_attention, *shared, kf_ctx, filt_bias[l], *tail)
        ks_out.append(k_c)
        vs_out.append(v_c)
        mods_lat = _adaln(c, w_ada[l], b_ada[l])
        kf_lat = _filter_spectrum(L_lat, *filt)
        k_cache = cache_ctx_k[:, l]
        v_cache = cache_ctx_v[:, l]
        rpb_l = rpb[l]
        attend_lat = lambda q, k, v: _neighbourhood_attention(q, k, v, k_cache, v_cache, rpb_l)
        xs, _, _ = _layer(xs, mods_lat, attend_lat, *shared, kf_lat, filt_bias[l], *tail)
    y_prompt = _rmsnorm(xc, final_g)
    y_sample = _rmsnorm(xs, final_g)
    state_ctx_k = jnp.stack(ks_out, axis=1)
    state_ctx_v = jnp.stack(vs_out, axis=1)
    return (y_prompt, y_sample, state_ctx_k, state_ctx_v)
```

```cpp
#include <hip/hip_runtime.h>
#include <cstdio>
#include <cstdint>
#ifndef MK_N_LAUNCHES
#define MK_N_LAUNCHES 1
#endif
namespace pg8 {
#define PG8_LAS __attribute__((address_space(3)))
typedef unsigned short bf16_t;
typedef short bf16x8 __attribute__((ext_vector_type(8)));
typedef float f32x4 __attribute__((ext_vector_type(4)));
typedef unsigned u32x4 __attribute__((ext_vector_type(4)));
constexpr int BM = 256, BK = 64, HALF = 128, HTB = HALF * BK * 2  , STAGE_BYTES = 8 * HTB, NXCD = 8, WGM = 8;

__host__ __device__ __forceinline__ int lds_byte(int r, int c) { const int st = (r >> 4) * 2 + (c >> 5), rr = r & 15, cc = c & 31, ob = rr * 64 + cc * 2; return st * 1024 + (ob ^ (((ob >> 9) & 1) << 5)); }
__host__ __device__ __forceinline__ void stage_rc(int b, int& R, int& C) { const int st = b / 1024, sb = b % 1024, swz = sb ^ (((sb >> 9) & 1) << 5); R = (st >> 1) * 16 + swz / 64; C = (st & 1) * 32 + (swz % 64) / 2; }
__host__ __device__ __forceinline__ int perm32(int rho) { const int n = rho >> 4, i = rho & 15; return 8 * (i >> 2) + 4 * n + (i & 3); }

struct Unit { int pm, pn; };
struct Gemm { const bf16_t* A; const bf16_t* Bt; int M, N, K; };

struct StaticOrder {
    int nM, nN, nwg, G, c;
    __host__ __device__ void init(int M, int N, int G_, int c_) { nM = M / BM; nN = N / BM; nwg = nM * nN; G = G_; c = c_; }
    __host__ __device__ bool next(int i, Unit& u) const {
        const long L = (long)i * G + c; if (L >= nwg) return false;
        int wgid = (int)L; { const int q = nwg / NXCD, r = nwg % NXCD, xcd = wgid % NXCD, off = wgid / NXCD; wgid = (xcd < r ? xcd * (q + 1) : r * (q + 1) + (xcd - r) * q) + off; }
        const int nig = WGM * nN, gid = wgid / nig, fm = gid * WGM, gsz = (nM - fm) < WGM ? (nM - fm) : WGM;
        u.pm = fm + ((wgid % nig) % gsz); u.pn = (wgid % nig) / gsz; return true;
    }
    __device__ __forceinline__ void a_ready(const Unit&) const {}
    __device__ __forceinline__ void done(const Unit&) const {}
};

__device__ __forceinline__ unsigned cvt_pk_bf16(float lo, float hi) { unsigned r; asm volatile("v_cvt_pk_bf16_f32 %0, %1, %2" : "=v"(r) : "v"(lo), "v"(hi)); return r; }
typedef float f32x2 __attribute__((ext_vector_type(2)));
template <class Epi, class Sched, bool ALIGN_EPI = false, bool SP2 = false>
__device__ __forceinline__ void gemm_phase(PG8_LAS unsigned char* lds, const Gemm g, const Sched& S, const Epi& E) {
    const int tid = threadIdx.x, wid = __builtin_amdgcn_readfirstlane(tid >> 6), lane = tid & 63, wr = wid >> 2, wc = wid & 3, fr = lane & 15, fq = lane >> 4;
    const int K = g.K, nt = K / BK;
    unsigned voffA[2], voffB[2];
#pragma unroll
    for (int i = 0; i < 2; ++i) { int R, C; stage_rc(tid * 16 + i * 8192, R, C); const int Rb = Epi::PERM ? ((R & ~31) + perm32(R & 31)) : R;
        voffA[i] = (unsigned)(R * K + C) * 2u; voffB[i] = (unsigned)(Rb * K + C) * 2u; }
    const size_t kstep = (size_t)(BK * 2);
    const size_t hstep = (size_t)HALF * K * 2;
    const size_t tstep = 2 * hstep;
    const unsigned ldsw = (unsigned)wid * 1024u;
    const int aoff = lds_byte(wr * 64 + fr, fq * 8), boff = lds_byte(wc * 32 + fr, fq * 8);
#define PG8_SA(b, h) (((b) * 2 + (h)) * HTB)
#define PG8_SB(b, h) ((4 + (b) * 2 + (h)) * HTB)
#define PG8_STAGE(bufoff, gbase, voff) do { _Pragma("unroll") for (int _i = 0; _i < 2; ++_i) \
        __builtin_amdgcn_global_load_lds((const unsigned*)((const char*)(gbase) + (voff)[_i]), (PG8_LAS unsigned*)(lds + (bufoff) + ldsw + _i * 8192), 16, 0, 0); } while (0)
#define PG8_LDA(dst, b, h) do { _Pragma("unroll") for (int m = 0; m < 4; ++m) _Pragma("unroll") for (int k = 0; k < 2; ++k) dst[m][k] = *(const PG8_LAS bf16x8*)(lds + PG8_SA(b, h) + aoff + m * 2048 + k * 1024); } while (0)
#define PG8_LDB(dst, b, h) do { _Pragma("unroll") for (int n = 0; n < 2; ++n) _Pragma("unroll") for (int k = 0; k < 2; ++k) dst[n][k] = *(const PG8_LAS bf16x8*)(lds + PG8_SB(b, h) + boff + n * 2048 + k * 1024); } while (0)
#define PG8_MMA(ai, bj, At, Bt) do { __builtin_amdgcn_s_setprio(1); _Pragma("unroll") for (int m = 0; m < 4; ++m) _Pragma("unroll") for (int n = 0; n < 2; ++n) _Pragma("unroll") for (int k = 0; k < 2; ++k) \
        acc[ai][bj][m][n] = __builtin_amdgcn_mfma_f32_16x16x32_bf16(Bt[n][k], At[m][k], acc[ai][bj][m][n], 0, 0, 0); __builtin_amdgcn_s_setprio(0); } while (0)
#define PG8_WAIT_V(n) asm volatile("s_waitcnt vmcnt(" #n ")" ::: "memory")
#define PG8_WAIT_L(n) asm volatile("s_waitcnt lgkmcnt(" #n ")" ::: "memory")
#define PG8_BAR __builtin_amdgcn_s_barrier()
#define PG8_SCHED __builtin_amdgcn_sched_barrier(0)
    Unit cur, nxt; int ui = 0;
    if (!S.next(0, cur)) return;
    f32x4 acc[2][2][4][2];
#pragma unroll
    for (int a = 0; a < 2; ++a)
#pragma unroll
        for (int b = 0; b < 2; ++b)
#pragma unroll
            for (int m = 0; m < 4; ++m)
#pragma unroll
                for (int n = 0; n < 2; ++n) acc[a][b][m][n] = (f32x4){0.f, 0.f, 0.f, 0.f};
    bf16x8 At[4][2], B0[2][2], B1[2][2];
    const char* cA = (const char*)g.A + (size_t)cur.pm * tstep; const char* cB = (const char*)g.Bt + (size_t)cur.pn * tstep;
    S.a_ready(cur);
    if constexpr (SP2) {
        PG8_STAGE(PG8_SB(0, 0), cB, voffB); PG8_STAGE(PG8_SB(0, 1), cB + hstep, voffB); PG8_STAGE(PG8_SA(0, 0), cA, voffA); PG8_STAGE(PG8_SA(0, 1), cA + hstep, voffA);
        if (wr == 1) PG8_BAR;
        PG8_WAIT_V(2); PG8_BAR;
        PG8_STAGE(PG8_SB(1, 0), cB + kstep, voffB); PG8_STAGE(PG8_SA(1, 0), cA + kstep, voffA); PG8_STAGE(PG8_SB(1, 1), cB + hstep + kstep, voffB);
        PG8_WAIT_V(6); PG8_BAR;
    } else {
        PG8_STAGE(PG8_SB(0, 0), cB, voffB); PG8_STAGE(PG8_SA(0, 0), cA, voffA); PG8_STAGE(PG8_SB(0, 1), cB + hstep, voffB); PG8_STAGE(PG8_SA(0, 1), cA + hstep, voffA);
        if (wr == 1) PG8_BAR;
        PG8_WAIT_V(4); PG8_BAR;
        PG8_STAGE(PG8_SB(1, 0), cB + kstep, voffB); PG8_STAGE(PG8_SA(1, 0), cA + kstep, voffA); PG8_STAGE(PG8_SB(1, 1), cB + hstep + kstep, voffB);
        PG8_WAIT_V(6); PG8_BAR;
    }
    for (;;) {
        const bool has_next = S.next(ui + 1, nxt);
        const char* nA = has_next ? (const char*)g.A + (size_t)nxt.pm * tstep : cA; const char* nB = has_next ? (const char*)g.Bt + (size_t)nxt.pn * tstep : cB;
        for (int t = 0; t < nt; t += 2) {
            const bool last = (t == nt - 2);
            const char* a1 = cA + (size_t)(t + 1) * kstep;
            const char* a2 = last ? nA : cA + (size_t)(t + 2) * kstep; const char* b2 = last ? nB : cB + (size_t)(t + 2) * kstep;
            const char* a3 = a2 + kstep; const char* b3 = b2 + kstep;
            if (last && has_next) S.a_ready(nxt);
            if constexpr (SP2) {
            PG8_LDB(B0, 0, 0); PG8_LDB(B1, 0, 1); PG8_SCHED; PG8_LDA(At, 0, 0); PG8_STAGE(PG8_SA(1, 1), a1 + hstep, voffA);
            PG8_WAIT_V(8); PG8_WAIT_L(0); PG8_BAR; PG8_MMA(0, 0, At, B0); PG8_MMA(0, 1, At, B1); PG8_BAR; PG8_SCHED;
            PG8_LDA(At, 0, 1); PG8_STAGE(PG8_SB(0, 0), b2, voffB); PG8_STAGE(PG8_SB(0, 1), b2 + hstep, voffB); PG8_STAGE(PG8_SA(0, 0), a2, voffA);
            PG8_WAIT_V(8); PG8_WAIT_L(0); PG8_BAR; PG8_MMA(1, 0, At, B0); PG8_MMA(1, 1, At, B1); PG8_BAR; PG8_SCHED;
            PG8_LDB(B0, 1, 0); PG8_LDB(B1, 1, 1); PG8_SCHED; PG8_LDA(At, 1, 0); PG8_STAGE(PG8_SA(0, 1), a2 + hstep, voffA);
            PG8_WAIT_V(8); PG8_WAIT_L(0); PG8_BAR; PG8_MMA(0, 0, At, B0); PG8_MMA(0, 1, At, B1); PG8_BAR; PG8_SCHED;
            PG8_LDA(At, 1, 1); PG8_STAGE(PG8_SB(1, 0), b3, voffB); PG8_STAGE(PG8_SB(1, 1), b3 + hstep, voffB); PG8_STAGE(PG8_SA(1, 0), a3, voffA);
            PG8_WAIT_V(8); PG8_WAIT_L(0); PG8_BAR; PG8_MMA(1, 0, At, B0); PG8_MMA(1, 1, At, B1); PG8_BAR; PG8_SCHED;
            } else {
            PG8_LDB(B0, 0, 0); PG8_SCHED; PG8_LDA(At, 0, 0); PG8_STAGE(PG8_SA(1, 1), a1 + hstep, voffA);
            PG8_WAIT_L(8); PG8_BAR; PG8_WAIT_L(0); PG8_MMA(0, 0, At, B0); PG8_BAR; PG8_SCHED;
            PG8_LDB(B1, 0, 1); PG8_STAGE(PG8_SB(0, 0), b2, voffB);
            PG8_BAR; PG8_WAIT_L(0); PG8_MMA(0, 1, At, B1); PG8_BAR;
            PG8_LDA(At, 0, 1); PG8_STAGE(PG8_SA(0, 0), a2, voffA);
            PG8_BAR; PG8_WAIT_L(0); PG8_MMA(1, 0, At, B0); PG8_BAR; PG8_SCHED;
            PG8_STAGE(PG8_SB(0, 1), b2 + hstep, voffB);
            PG8_WAIT_V(6); PG8_BAR; PG8_MMA(1, 1, At, B1); PG8_BAR;
            PG8_LDB(B0, 1, 0); PG8_SCHED; PG8_LDA(At, 1, 0); PG8_STAGE(PG8_SA(0, 1), a2 + hstep, voffA);
            PG8_WAIT_L(8); PG8_BAR; PG8_WAIT_L(0); PG8_MMA(0, 0, At, B0); PG8_BAR; PG8_SCHED;
            PG8_LDB(B1, 1, 1); PG8_STAGE(PG8_SB(1, 0), b3, voffB);
            PG8_BAR; PG8_WAIT_L(0); PG8_MMA(0, 1, At, B1); PG8_BAR;
            PG8_LDA(At, 1, 1); PG8_STAGE(PG8_SA(1, 0), a3, voffA);
            PG8_BAR; PG8_WAIT_L(0); PG8_MMA(1, 0, At, B0); PG8_BAR; PG8_SCHED;
            PG8_STAGE(PG8_SB(1, 1), b3 + hstep, voffB);
            PG8_WAIT_V(6); PG8_BAR; PG8_MMA(1, 1, At, B1); PG8_BAR;
            }
        }
        if constexpr (ALIGN_EPI) { if (wr == 0) PG8_BAR; }
        if constexpr (!Epi::AFTER_DRAIN) { E(acc, cur, wr, wc, fr, fq); S.done(cur); }
        if (!has_next) break;
#pragma unroll
        for (int a = 0; a < 2; ++a)
#pragma unroll
            for (int b = 0; b < 2; ++b)
#pragma unroll
                for (int m = 0; m < 4; ++m)
#pragma unroll
                    for (int n = 0; n < 2; ++n) acc[a][b][m][n] = (f32x4){0.f, 0.f, 0.f, 0.f};
        cur = nxt; cA = nA; cB = nB; ++ui;
        if constexpr (ALIGN_EPI) { if (wr == 1) PG8_BAR; }
    }
    PG8_WAIT_V(0);
    if constexpr (!ALIGN_EPI) { if (wr == 0) PG8_BAR; }
    PG8_BAR;
    if constexpr (Epi::AFTER_DRAIN) { E.fused(acc, cur, wr, wc, fr, fq, lds, wid, lane); S.done(cur); }
#undef PG8_SA
#undef PG8_SB
#undef PG8_STAGE
#undef PG8_LDA
#undef PG8_LDB
#undef PG8_MMA
#undef PG8_WAIT_V
#undef PG8_WAIT_L
#undef PG8_BAR
#undef PG8_SCHED
}
}

constexpr int NWAVES = 8;
constexpr int D = 1024, MC = 8192, ML = 4096, M = MC + ML, LC = 256, LL = 1024;
constexpr int NH = 8, DH = 64, AW = 512, HC = 512, INC = 3072, QKVC = 1536, HYC = 1536, DFF = 2816, UPC = 5632;
constexpr float EPS = 1e-6f;
constexpr float C2 = 0.125f * 1.4426950408889634f;
constexpr float LOG2E = 1.4426950408889634f;
constexpr float MIN_DECAY = -3.0701134573253943f, MAX_DECAY = -15.350567286626973f;
constexpr int TLL = 2 * LL + 128, OFFL = LL + 64, TLC = 2 * LC + 128, OFFC = LC + 64;

constexpr size_t MiB = 1u << 20;
constexpr size_t WS_CTL = 0, CTL_ZERO_BYTES = 64 * 1024;
constexpr size_t WS_MODS = 1 * MiB;
constexpr size_t WS_WIN = 2 * MiB;
constexpr size_t WS_WOUT = 8 * MiB;
constexpr size_t WS_WUP = 10 * MiB;
constexpr size_t WS_WDN = 21 * MiB;
constexpr size_t WS_BT = 27 * MiB;
constexpr size_t WS_KRL = 29 * MiB;
constexpr size_t WS_KRC = 38 * MiB;
constexpr size_t WS_CK = 41 * MiB, WS_CV = 42 * MiB;
constexpr size_t WS_XN = 43 * MiB;
constexpr size_t WS_ACT = 27 * MiB;
constexpr size_t WS_U = 95 * MiB;
constexpr size_t WS_QH = 95 * MiB, WS_KH = 107 * MiB, WS_VH = 119 * MiB;
constexpr size_t WS_HYT = 131 * MiB;
constexpr size_t WS_AO = 167 * MiB;
constexpr size_t WS_HYOT = 191 * MiB;
constexpr size_t WS_END = 227 * MiB;
static_assert(WS_XN + (size_t)M * D * 2 <= WS_U && WS_ACT + (size_t)M * DFF * 2 <= WS_U && WS_U + (size_t)M * UPC * 2 <= WS_END, "ws map");
static_assert(WS_KRL + (size_t)2 * 512 * 2 * TLL * 2 <= WS_KRC && WS_KRC + (size_t)2 * 512 * 2 * TLC * 2 <= WS_CK && WS_BT + (size_t)8 * 15 * 64 * 64 * 4 <= WS_KRL, "ws map 2");
static_assert(WS_WDN + (size_t)D * DFF * 2 <= WS_BT && WS_WUP + (size_t)UPC * D * 2 <= WS_WDN, "ws map 3");
constexpr int CW_Q = 64;
constexpr int CW_BAR = 4096;

constexpr int WAVE_LDS = 18432;
constexpr int LDS_BYTES = NWAVES * WAVE_LDS;
constexpr int MISC_OFF = LDS_BYTES - 64;

#define GAS __attribute__((address_space(1)))
#define LAS __attribute__((address_space(3)))
typedef unsigned short bf16;
typedef unsigned v4u __attribute__((ext_vector_type(4)));
typedef unsigned v2u __attribute__((ext_vector_type(2)));
typedef float f32x4 __attribute__((ext_vector_type(4)));
typedef float f32x16 __attribute__((ext_vector_type(16)));
typedef short bf16x8 __attribute__((ext_vector_type(8)));
typedef short s16x4 __attribute__((ext_vector_type(4)));
typedef GAS unsigned gu32;
typedef float f32x2_t __attribute__((ext_vector_type(2))); typedef __bf16 bf16x2_t __attribute__((ext_vector_type(2)));
#define RLX_AGENT __ATOMIC_RELAXED, __HIP_MEMORY_SCOPE_AGENT
#define LDS_WAIT() asm volatile("s_waitcnt lgkmcnt(0)" ::: "memory")
#define VM_WAIT() asm volatile("s_waitcnt vmcnt(0)" ::: "memory")
__device__ __forceinline__ unsigned pk2(float lo, float hi) { f32x2_t v = {lo, hi}; bf16x2_t b = __builtin_convertvector(v, bf16x2_t); return __builtin_bit_cast(unsigned, b); }
__device__ __forceinline__ unsigned short f2bf(float f) { return (unsigned short)(pk2(f, 0.f) & 0xffffu); }
__device__ __forceinline__ float bflo(unsigned u) { return __uint_as_float(u << 16); }
__device__ __forceinline__ float bfhi(unsigned u) { return __uint_as_float(u & 0xffff0000u); }
__device__ __forceinline__ float bf1(unsigned short b) { return __uint_as_float((unsigned)b << 16); }
__device__ __forceinline__ float wave_sum(float v) {
#pragma unroll
    for (int o = 1; o < 64; o <<= 1) v += __shfl_xor(v, o);
    return v;
}
__device__ __forceinline__ float silu_f(float x) { return x / (1.0f + __expf(-x)); }
#define XB_TMO      128
#define XB_XCNT(j)  (256  + 64 * (j))
#define XB_XSUB(j)  (1280 + 64 * (j))
#define XB_XGEN(j)  (2304 + 64 * (j))
#define XB_TOP      3328
#define XB_TOPGEN   3392
#define XCD_BAR_WORDS 3456
#define XB_SPIN_CAP (1u << 18)

__device__ __forceinline__ unsigned xb_ld(unsigned* p)              { return __hip_atomic_load(p, __ATOMIC_RELAXED, __HIP_MEMORY_SCOPE_AGENT); }
__device__ __forceinline__ unsigned xb_add(unsigned* p, unsigned v) { return __hip_atomic_fetch_add(p, v, __ATOMIC_RELAXED, __HIP_MEMORY_SCOPE_AGENT); }
__device__ __forceinline__ unsigned xb_xcc_id() { return (unsigned)__builtin_amdgcn_s_getreg((3 << 11) | 20) & 0xFu; }
#define XB_SPIN(cond, bar) do { unsigned _sp = 0; while (cond) { __builtin_amdgcn_s_sleep(1); \
    if ((++_sp & 255u) == 0u) { if (xb_ld(&(bar)[XB_TMO])) break; if (_sp > XB_SPIN_CAP) { atomicAdd(&(bar)[XB_TMO], 1u); break; } } } } while (0)

struct XcdBarrier {
    unsigned* bar; unsigned x;
    volatile LAS unsigned* st;
};

__device__ __forceinline__ XcdBarrier xcd_barrier_post(unsigned* bar, volatile LAS unsigned* st) {
    XcdBarrier b; b.bar = bar; b.x = xb_xcc_id(); b.st = st;
    if (threadIdx.x == 0) (void)xb_add(&bar[XB_XCNT(b.x)], 1u);
    return b;
}
__device__ __forceinline__ void xcd_barrier_complete(unsigned* bar, unsigned x, unsigned& nloc, unsigned& nx) {
    const unsigned G = gridDim.x * gridDim.y * gridDim.z;
    unsigned sum, cnt, mine, sp = 0u;
    for (;;) {
        sum = 0u; cnt = 0u; mine = 0u;
#pragma unroll
        for (unsigned j = 0; j < 16; ++j) { const unsigned c = xb_ld(&bar[XB_XCNT(j)]); sum += c; cnt += (c > 0u) ? 1u : 0u; mine = (j == x) ? c : mine; }
        if (sum == G) break;
        __builtin_amdgcn_s_sleep(1);
        if ((++sp & 255u) == 0u) { if (xb_ld(&bar[XB_TMO])) break; if (sp > XB_SPIN_CAP) { atomicAdd(&bar[XB_TMO], 1u); break; } }
    }
    nloc = mine > 0u ? mine : 1u; nx = cnt > 0u ? cnt : 1u;
}

__device__ __forceinline__ void xcd_barrier(const XcdBarrier& b) {
    asm volatile("s_waitcnt vmcnt(0)" ::: "memory");
    __syncthreads();
    if (threadIdx.x == 0) {
        unsigned* bar = b.bar;
        __builtin_amdgcn_s_waitcnt(0);
        unsigned nloc = b.st[0], nx = b.st[1];
        if (nloc == 0u) { xcd_barrier_complete(bar, b.x, nloc, nx); b.st[0] = nloc; b.st[1] = nx; }
        const unsigned old = xb_add(&bar[XB_XSUB(b.x)], 1u);
        const unsigned gen = old / nloc;
        if (old + 1u == (gen + 1u) * nloc) {
            __builtin_amdgcn_fence(__ATOMIC_RELEASE, "agent");
            asm volatile("s_waitcnt vmcnt(0)" ::: "memory");
            const unsigned og = xb_add(&bar[XB_TOP], 1u);
            const unsigned tg = og / nx;
            if (og + 1u == (tg + 1u) * nx) xb_add(&bar[XB_TOPGEN], 1u);
            else XB_SPIN(xb_ld(&bar[XB_TOPGEN]) == tg, bar);
            __builtin_amdgcn_fence(__ATOMIC_ACQUIRE, "agent");
            xb_add(&bar[XB_XGEN(b.x)], 1u);
            asm volatile("s_waitcnt vmcnt(0)" ::: "memory");
        } else {
            XB_SPIN(xb_ld(&bar[XB_XGEN(b.x)]) == gen, bar);
            __builtin_amdgcn_fence(__ATOMIC_ACQUIRE, "agent");
            asm volatile("s_waitcnt vmcnt(0)" ::: "memory");
        }
    }
    __syncthreads();
}

struct Args { const float* in[29]; float* out; unsigned char* ws; int ph_lo, ph_hi; };
static_assert(sizeof(Args) == 31 * 8 + 8, "Args has no padding");
struct Frame {
    LAS unsigned char* lds; LAS unsigned char* wl;
    unsigned char* ws; float* out;
    int tid, lane, wave, G;
};
enum { I_XP = 0, I_XS = 1, I_CK = 2, I_CV = 3, I_C = 4, I_CCTX = 5, I_WADA = 6, I_BADA = 7, I_N1G = 8, I_WIN = 9, I_RPB = 10, I_HCW = 11, I_HCB = 12, I_FW1 = 13, I_FB1 = 14, I_FW2 = 15, I_FB2 = 16,
       I_FW3 = 17, I_FB3 = 18, I_FFREQ = 19, I_FBIAS = 20, I_GNG = 21, I_WOUT = 22, I_N2G = 23, I_WUP = 24, I_FCW = 25, I_FCB = 26, I_WDN = 27, I_FING = 28 };
#define W_CTL   ((gu32*)(F.ws + WS_CTL))
#define W_MODS  ((float*)(F.ws + WS_MODS))
#define W_BT    ((float*)(F.ws + WS_BT))
#define W_WIN   ((bf16*)(F.ws + WS_WIN))
#define W_WOUT  ((bf16*)(F.ws + WS_WOUT))
#define W_WUP   ((bf16*)(F.ws + WS_WUP))
#define W_WDN   ((bf16*)(F.ws + WS_WDN))
#define W_KRL   ((bf16*)(F.ws + WS_KRL))
#define W_KRC   ((bf16*)(F.ws + WS_KRC))
#define W_CK    ((bf16*)(F.ws + WS_CK))
#define W_CV    ((bf16*)(F.ws + WS_CV))
#define W_XN    ((bf16*)(F.ws + WS_XN))
#define W_ACT   ((bf16*)(F.ws + WS_ACT))
#define W_U     ((bf16*)(F.ws + WS_U))
#define W_QH    ((bf16*)(F.ws + WS_QH))
#define W_KH    ((bf16*)(F.ws + WS_KH))
#define W_VH    ((bf16*)(F.ws + WS_VH))
#define W_HYT   ((bf16*)(F.ws + WS_HYT))
#define W_AO    ((bf16*)(F.ws + WS_AO))
#define W_HYOT  ((bf16*)(F.ws + WS_HYOT))
__device__ __forceinline__ const float* xrow_ptr(const float* xp, const float* xs, int m) { return m < MC ? xp + (size_t)m * D : xs + (size_t)(m - MC) * D; }
__device__ __forceinline__ int midx_of(int m) { return m < MC ? 0 : 1 + ((m - MC) >> 10); }

__device__ __forceinline__ void p0_transpose_item(const float* W, int K, int N, bf16* WT, int row_off, LAS float* scr, int item, int lane) {
    const int nblk = N / 32, kb = item / nblk, nb = item % nblk, k0 = 64 * kb, n0 = 32 * nb;
#pragma unroll 8
    for (int i = 0; i < 32; ++i) { const int kk = 2 * i + (lane >> 5); scr[kk * 33 + (lane & 31)] = W[(size_t)(k0 + kk) * N + n0 + (lane & 31)]; }
    LDS_WAIT(); asm volatile("" ::: "memory");
    const int c = lane & 7;
#pragma unroll
    for (int j = 0; j < 4; ++j) { const int n = (lane >> 3) + 8 * j; const LAS float* s = scr + (8 * c) * 33 + n;
        v4u o; o.x = pk2(s[0 * 33], s[1 * 33]); o.y = pk2(s[2 * 33], s[3 * 33]); o.z = pk2(s[4 * 33], s[5 * 33]); o.w = pk2(s[6 * 33], s[7 * 33]);
        *(GAS v4u*)(WT + (size_t)(row_off + n0 + n) * K + k0 + 8 * c) = o; }
    LDS_WAIT(); asm volatile("" ::: "memory");
}
__device__ __forceinline__ void adaln_block(const Frame& F, const Args& A, int it) {
    const int col0 = 32 * it, w = F.wave, lane = F.lane, sub = lane >> 3, c4 = (lane & 7) * 4;
    float acc[5][4];
#pragma unroll
    for (int v = 0; v < 5; ++v)
#pragma unroll
        for (int e = 0; e < 4; ++e) acc[v][e] = 0.f;
    const float* wa = A.in[I_WADA] + col0 + c4;
#pragma unroll 4
    for (int j = 0; j < 16; ++j) {
        const int k = 128 * w + 8 * j + sub;
        const f32x4 wv = *(const GAS f32x4*)(wa + (size_t)k * 6144);
        float s[5]; s[0] = silu_f(A.in[I_CCTX][k]);
#pragma unroll
        for (int v = 1; v < 5; ++v) s[v] = silu_f(A.in[I_C][(v - 1) * D + k]);
#pragma unroll
        for (int v = 0; v < 5; ++v)
#pragma unroll
            for (int e = 0; e < 4; ++e) acc[v][e] += s[v] * wv[e];
    }
#pragma unroll
    for (int v = 0; v < 5; ++v)
#pragma unroll
        for (int e = 0; e < 4; ++e) { float a = acc[v][e]; a += __shfl_xor(a, 8); a += __shfl_xor(a, 16); a += __shfl_xor(a, 32); acc[v][e] = a; }
    LAS float* red = (LAS float*)F.lds;
    if (lane < 8) {
#pragma unroll
        for (int v = 0; v < 5; ++v)
#pragma unroll
            for (int e = 0; e < 4; ++e) red[(w * 5 + v) * 32 + c4 + e] = acc[v][e];
    }
    __syncthreads();
    if (F.tid < 160) { const int v = F.tid >> 5, cc = F.tid & 31; float s = 0.f;
#pragma unroll
        for (int w8 = 0; w8 < 8; ++w8) s += red[(w8 * 5 + v) * 32 + cc];
        W_MODS[v * 6144 + col0 + cc] = s + A.in[I_BADA][col0 + cc]; }
    __syncthreads();
}
__device__ __forceinline__ void filter_item(const Frame& F, const Args& A, int it) {
    const int pc = it >> 3, cc = it & 7, lane = F.lane;
    LAS float* zb = (LAS float*)F.wl;
    LAS float* h1 = (LAS float*)(F.wl + 1280);
    LAS float* h2 = (LAS float*)(F.wl + 1280 + 4096);
    for (int pp = 0; pp < 16; ++pp) {
        const int p = pc * 16 + pp; const float t = (float)p * (1.0f / 1024.0f);
        float val = t;
        if (lane >= 1 && lane <= 16) { const int f = (lane - 1) & 7; const float ang = (6.283185307179586f * t) * (float)(f + 1); val = (lane <= 8) ? cosf(ang) : sinf(ang); }
        if (lane < 17) zb[pp * 20 + lane] = val;
    }
    LDS_WAIT(); asm volatile("" ::: "memory");
    const float fq = A.in[I_FFREQ][lane];
    { float w1c[17];
#pragma unroll
      for (int e = 0; e < 17; ++e) w1c[e] = A.in[I_FW1][e * 64 + lane];
      const float b1v = A.in[I_FB1][lane];
      for (int pp = 0; pp < 16; ++pp) { float s = b1v;
#pragma unroll
          for (int e = 0; e < 17; ++e) s += zb[pp * 20 + e] * w1c[e];
          h1[pp * 64 + lane] = sinf(fq * s); } }
    LDS_WAIT(); asm volatile("" ::: "memory");
    { float w2c[64];
#pragma unroll
      for (int i = 0; i < 64; ++i) w2c[i] = A.in[I_FW2][i * 64 + lane];
      const float b2v = A.in[I_FB2][lane];
      for (int pp = 0; pp < 16; ++pp) { float s = b2v;
#pragma unroll
          for (int i = 0; i < 64; i += 4) { const f32x4 hv = *(const LAS f32x4*)(h1 + pp * 64 + i); s += hv[0] * w2c[i] + hv[1] * w2c[i + 1] + hv[2] * w2c[i + 2] + hv[3] * w2c[i + 3]; }
          h2[lane * 16 + pp] = sinf(fq * s); } }
    LDS_WAIT(); asm volatile("" ::: "memory");
    float acc[16][4];
#pragma unroll
    for (int pp = 0; pp < 16; ++pp)
#pragma unroll
        for (int q = 0; q < 4; ++q) acc[pp][q] = 0.f;
    const float* w3p = A.in[I_FW3] + cc * 256 + lane;
#pragma unroll 2
    for (int j = 0; j < 64; ++j) {
        float w3v[4];
#pragma unroll
        for (int q = 0; q < 4; ++q) w3v[q] = w3p[(size_t)j * 2048 + q * 64];
        float hv[16];
#pragma unroll
        for (int k = 0; k < 4; ++k) { const f32x4 t4 = *(const LAS f32x4*)(h2 + j * 16 + 4 * k); hv[4 * k] = t4[0]; hv[4 * k + 1] = t4[1]; hv[4 * k + 2] = t4[2]; hv[4 * k + 3] = t4[3]; }
#pragma unroll
        for (int pp = 0; pp < 16; ++pp)
#pragma unroll
            for (int q = 0; q < 4; ++q) acc[pp][q] += hv[pp] * w3v[q];
    }
#pragma unroll
    for (int q = 0; q < 4; ++q) {
        const int col = cc * 256 + q * 64 + lane, o = col >> 10, dir = (col >> 9) & 1, c = col & 511;
        const float b3v = A.in[I_FB3][col];
        const float delta = fabsf(MIN_DECAY + (MAX_DECAY - MIN_DECAY) * ((float)c / 511.0f));
        const float fb = dir == 0 ? A.in[I_FBIAS][o * 512 + c] : 0.f;
        bf16* rowL = W_KRL + (size_t)((o * 512 + c) * 2) * TLL;
        bf16* rowC = W_KRC + (size_t)((o * 512 + c) * 2) * TLC;
#pragma unroll
        for (int pp = 0; pp < 16; ++pp) {
            const int p = pc * 16 + pp; const float t = (float)p * (1.0f / 1024.0f);
            float val = (acc[pp][q] + b3v) * expf(-t * delta);
            if (p == 0) val += fb;
            if (dir == 0 || p > 0) {
                const unsigned short bv = f2bf(val);
                const int idx = dir ? OFFL + p : OFFL - p;
                rowL[idx] = bv; rowL[TLL + idx + 1] = bv;
                if ((p & 3) == 0) { const int P = p >> 2, idc = dir ? OFFC + P : OFFC - P; rowC[idc] = bv; rowC[TLC + idc + 1] = bv; }
            }
        }
    }
    LDS_WAIT(); asm volatile("" ::: "memory");
}
__device__ __forceinline__ void krpad_item(const Frame& F, const Args& A, int zi) {
    const int type = zi >> 11, row = zi & 2047, copy = row & 1, lane = F.lane;
    const int L = type ? LC : LL, TL = 2 * L + 128;
    bf16* base = (type ? W_KRC : W_KRL) + (size_t)row * TL;
    for (int idx = lane; idx < 66; idx += 64) if (idx < 65 + copy) base[idx] = 0;
    { const int idx = 2 * L + 64 + lane; if (idx >= 2 * L + 64 + copy) base[idx] = 0; }
}
__device__ __forceinline__ void bias_item(const Frame& F, const Args& A, int it) {
    const float* rp = A.in[I_RPB] + (size_t)it * 31; float* dst = W_BT + (size_t)it * 4096;
    for (int k = 0; k < 64; ++k) { const int e = F.lane + 64 * k, qcol = e >> 6, kcol = e & 63;
        int cs = qcol - 8; cs = cs < 0 ? 0 : (cs > 48 ? 48 : cs);
        const bool valid = kcol >= cs && kcol < cs + 16;
        int dc = kcol - qcol; dc = dc < -15 ? -15 : (dc > 15 ? 15 : dc);
        dst[e] = valid ? rp[dc + 15] * LOG2E : -1e30f; }
}
__device__ __forceinline__ void ckv_item(const Frame& F, const Args& A, int it) {
    const float* src = (it < 1024 ? A.in[I_CK] : A.in[I_CV]) + (size_t)(it & 1023) * 512 + F.lane * 8;
    bf16* dst = (it < 1024 ? W_CK : W_CV) + (size_t)(it & 1023) * 512 + F.lane * 8;
    const f32x4 a = *(const GAS f32x4*)src, b = *(const GAS f32x4*)(src + 4);
    v4u o; o.x = pk2(a[0], a[1]); o.y = pk2(a[2], a[3]); o.z = pk2(b[0], b[1]); o.w = pk2(b[2], b[3]);
    *(GAS v4u*)dst = o;
}
__device__ __forceinline__ void p0a_phase(const Frame& F, const Args& A) {
    for (int it = blockIdx.x; it < 192; it += F.G) adaln_block(F, A, it);
    const int gw = blockIdx.x * NWAVES + F.wave, NGW = F.G * NWAVES;
    constexpr int I_F = 512, I_IN = (D / 64) * (INC / 32), I_OUT = (D / 64) * (D / 32), I_UP = (D / 64) * (UPC / 32), I_DN = (DFF / 64) * (D / 32), I_PAD = 4096, I_BT = 120, I_CKV = 2048;
    LAS float* scr = (LAS float*)F.wl;
#pragma unroll 1
    for (int it = gw; it < I_F; it += NGW) filter_item(F, A, it);
#pragma unroll 1
    for (int it = (gw + NGW - 512) % NGW; it < I_IN; it += NGW) p0_transpose_item(A.in[I_WIN], D, INC, W_WIN, 0, scr, it, F.lane);
#pragma unroll 1
    for (int it = gw; it < I_UP; it += NGW) p0_transpose_item(A.in[I_WUP], D, UPC, W_WUP, 0, scr, it, F.lane);
#pragma unroll 1
    for (int it = (gw + NGW - 768) % NGW; it < I_DN; it += NGW) p0_transpose_item(A.in[I_WDN], DFF, D, W_WDN, 0, scr, it, F.lane);
#pragma unroll 1
    for (int it = (gw + NGW - 128) % NGW; it < I_OUT; it += NGW) p0_transpose_item(A.in[I_WOUT], D, D, W_WOUT, 0, scr, it, F.lane);
#pragma unroll 1
    for (int it = gw; it < I_PAD; it += NGW) krpad_item(F, A, it);
#pragma unroll 1
    for (int it = (gw + NGW - 1900) % NGW; it < I_BT; it += NGW) bias_item(F, A, it);
#pragma unroll 1
    for (int it = gw; it < I_CKV; it += NGW) ckv_item(F, A, it);
}

__device__ __forceinline__ void norm_mod_row(const float* xrow, const float* g, const float* sc, const float* sh, bf16* orow, int lane) {
    const GAS f32x4* xr = (const GAS f32x4*)xrow + lane;
    f32x4 v[4]; float s = 0.f;
#pragma unroll
    for (int j = 0; j < 4; ++j) { v[j] = xr[64 * j]; s += (v[j][0] * v[j][0] + v[j][1] * v[j][1]) + (v[j][2] * v[j][2] + v[j][3] * v[j][3]); }
    const float rs = 1.0f / sqrtf(wave_sum(s) * (1.0f / D) + EPS);
    GAS v2u* o8 = (GAS v2u*)orow + lane;
#pragma unroll
    for (int j = 0; j < 4; ++j) { const int col = 4 * lane + 256 * j;
        const f32x4 g4 = *(const f32x4*)(g + col), s4 = *(const f32x4*)(sc + col), h4 = *(const f32x4*)(sh + col);
        const f32x4 y = (v[j] * rs) * g4 * (s4 + 1.0f) + h4;
        v2u w; w.x = pk2(y[0], y[1]); w.y = pk2(y[2], y[3]); o8[64 * j] = w; }
}
__device__ __forceinline__ void p0b_phase(const Frame& F, const Args& A) {
    const int gw = blockIdx.x * NWAVES + F.wave, NGW = F.G * NWAVES;
    for (int m = gw; m < M; m += NGW) { const float* md = W_MODS + midx_of(m) * 6144;
        norm_mod_row(xrow_ptr(A.in[I_XP], A.in[I_XS], m), A.in[I_N1G], md + 1024, md, W_XN + (size_t)m * D, F.lane); }
}
__device__ __forceinline__ void p3b_phase(const Frame& F, const Args& A) {
    const int gw = blockIdx.x * NWAVES + F.wave, NGW = F.G * NWAVES;
    for (int m = gw; m < M; m += NGW) { const float* md = W_MODS + midx_of(m) * 6144;
        norm_mod_row(F.out + (size_t)m * D, A.in[I_N2G], md + 4096, md + 3072, W_XN + (size_t)m * D, F.lane); }
}
__device__ __forceinline__ void p6_phase(const Frame& F, const Args& A) {
    const int gw = blockIdx.x * NWAVES + F.wave, NGW = F.G * NWAVES;
    for (int m = gw; m < M; m += NGW) {
        GAS f32x4* xr = (GAS f32x4*)(F.out + (size_t)m * D) + F.lane;
        f32x4 v[4]; float s = 0.f;
#pragma unroll
        for (int j = 0; j < 4; ++j) { v[j] = xr[64 * j]; s += (v[j][0] * v[j][0] + v[j][1] * v[j][1]) + (v[j][2] * v[j][2] + v[j][3] * v[j][3]); }
        const float rs = 1.0f / sqrtf(wave_sum(s) * (1.0f / D) + EPS);
#pragma unroll
        for (int j = 0; j < 4; ++j) { const f32x4 g4 = *(const f32x4*)(A.in[I_FING] + 4 * F.lane + 256 * j); xr[64 * j] = (v[j] * rs) * g4; }
    }
}

struct EpiQKV {
    static constexpr bool PERM = true, AFTER_DRAIN = false;
    bf16* QH; float* state_k;
    __device__ __forceinline__ void operator()(const pg8::f32x4 (&acc)[2][2][4][2], const pg8::Unit& u, int wr, int wc, int fr, int fq) const {
        const int which = u.pn >> 1; const float sc = which == 0 ? C2 : 1.0f;
        bf16* dstb = QH + (size_t)which * ((size_t)NH * M * DH);
        float* st = state_k + (size_t)(which == 2 ? 1 : 0) * ((size_t)32 * NH * LC * DH);
#pragma unroll
        for (int ai = 0; ai < 2; ++ai)
#pragma unroll
            for (int m = 0; m < 4; ++m) { const int row = u.pm * 256 + ai * 128 + wr * 64 + m * 16 + fr;
#pragma unroll
                for (int bj = 0; bj < 2; ++bj) { const int hc = (u.pn & 1) * 256 + bj * 128 + wc * 32 + 8 * fq, h = hc >> 6, d = hc & 63;
                    const f32x4 v0 = acc[ai][bj][m][0] * sc, v1 = acc[ai][bj][m][1] * sc;
                    v4u w; w.x = pk2(v0[0], v0[1]); w.y = pk2(v0[2], v0[3]); w.z = pk2(v1[0], v1[1]); w.w = pk2(v1[2], v1[3]);
                    *(GAS v4u*)(dstb + ((size_t)h * M + row) * DH + d) = w;
                    if (which != 0 && row < MC) { float* sp = st + ((size_t)((row >> 8) * NH + h) * LC + (row & 255)) * DH + d;
                        *(GAS f32x4*)sp = v0; *(GAS f32x4*)(sp + 4) = v1; } } }
    }
};
struct EpiBf16Plain {
    static constexpr bool PERM = true, AFTER_DRAIN = false;
    bf16* O; int ldc;
    __device__ __forceinline__ void operator()(const pg8::f32x4 (&acc)[2][2][4][2], const pg8::Unit& u, int wr, int wc, int fr, int fq) const {
#pragma unroll
        for (int ai = 0; ai < 2; ++ai)
#pragma unroll
            for (int m = 0; m < 4; ++m) { bf16* rowp = O + (size_t)(u.pm * 256 + ai * 128 + wr * 64 + m * 16 + fr) * ldc + u.pn * 256 + wc * 32 + 8 * fq;
#pragma unroll
                for (int bj = 0; bj < 2; ++bj) { const f32x4 v0 = acc[ai][bj][m][0], v1 = acc[ai][bj][m][1];
                    v4u w; w.x = pk2(v0[0], v0[1]); w.y = pk2(v0[2], v0[3]); w.z = pk2(v1[0], v1[1]); w.w = pk2(v1[2], v1[3]);
                    *(GAS v4u*)(rowp + bj * 128) = w; } }
    }
};
struct EpiGatedRes {
    static constexpr bool PERM = false, AFTER_DRAIN = false;
    const float* xp; const float* xs; float* out; const float* gate;
    __device__ __forceinline__ void operator()(const pg8::f32x4 (&acc)[2][2][4][2], const pg8::Unit& u, int wr, int wc, int fr, int fq) const {
        const int row00 = u.pm * 256; const float* gt = gate + midx_of(row00) * 6144;
        const int col0 = u.pn * 256 + wc * 32 + 4 * fq;
        f32x4 gv[2][2];
#pragma unroll
        for (int bj = 0; bj < 2; ++bj)
#pragma unroll
            for (int n = 0; n < 2; ++n) gv[bj][n] = *(const f32x4*)(gt + col0 + bj * 128 + n * 16);
#pragma unroll
        for (int ai = 0; ai < 2; ++ai)
#pragma unroll
            for (int m = 0; m < 4; ++m) { const int row = row00 + ai * 128 + wr * 64 + m * 16 + fr;
                const float* bp = xp ? (row < MC ? xp + (size_t)row * D : xs + (size_t)(row - MC) * D) : out + (size_t)row * D;
                float* op = out + (size_t)row * D;
#pragma unroll
                for (int bj = 0; bj < 2; ++bj)
#pragma unroll
                    for (int n = 0; n < 2; ++n) { const int c = col0 + bj * 128 + n * 16; const f32x4 bs = *(const GAS f32x4*)(bp + c);
                        *(GAS f32x4*)(op + c) = bs + gv[bj][n] * acc[ai][bj][m][n]; }
                if (m & 1) asm volatile("" ::: "memory"); }
    }
};

__device__ __forceinline__ s16x4 vtr(const LAS unsigned char* p) { typedef short v4i16_t __attribute__((ext_vector_type(4)));
    return __builtin_bit_cast(s16x4, __builtin_amdgcn_ds_read_tr16_b64_v4i16((LAS v4i16_t*)p)); }
__device__ __forceinline__ float swap_max(float m) { auto rr = __builtin_amdgcn_permlane32_swap(__float_as_uint(m), __float_as_uint(m), false, false); return fmaxf(__uint_as_float(rr[0]), __uint_as_float(rr[1])); }
__device__ __forceinline__ float swap_sum(float m) { auto rr = __builtin_amdgcn_permlane32_swap(__float_as_uint(m), __float_as_uint(m), false, false); return __uint_as_float(rr[0]) + __uint_as_float(rr[1]); }
template <bool LAT>
__device__ __forceinline__ void attn_item(const Frame& F, const Args& A, int it) {
    const int lane = F.lane, r32 = lane & 31, hi = lane >> 5;
    int h, b, m0, r = 0, rs = 0, qcol = 0;
    if (LAT) { const int half = it & 1; r = (it >> 1) & 15; h = (it >> 5) & 7; b = it >> 8; m0 = MC + b * LL + r * 64 + half * 32; qcol = half * 32 + r32; rs = r - 4; rs = rs < 0 ? 0 : (rs > 8 ? 8 : rs); }
    else { const int qb = it & 7, bh = it >> 3; b = bh >> 3; h = bh & 7; m0 = b * LC + qb * 32; }
    const bf16* Qw = W_QH + ((size_t)h * M + m0) * DH;
    bf16x8 qr[4];
#pragma unroll
    for (int d0 = 0; d0 < 4; ++d0) qr[d0] = *(const GAS bf16x8*)(Qw + r32 * DH + d0 * 16 + hi * 8);
    float m_run = -1e30f, l_run = 0.f; f32x16 o0, o1;
#pragma unroll
    for (int i = 0; i < 16; ++i) { o0[i] = 0.f; o1[i] = 0.f; }
    LAS unsigned char* vimg = F.wl; LAS float* wsf = (LAS float*)(F.wl + 8192);
    const LAS unsigned char* vp = vimg + ((lane >> 4) & 1) * 32 + (lane & 3) * 8 + (4 * hi + ((lane & 15) >> 2)) * 64;
    constexpr int NT = LAT ? 12 : 4;
    for (int t = 0; t < NT; ++t) {
        const bf16 *Kt, *Vt;
        if (LAT && t >= 8) { const size_t row = (size_t)(b * NH + h) * 256 + (t - 8) * 64; Kt = W_CK + row * DH; Vt = W_CV + row * DH; }
        else { const size_t row = (size_t)h * M + (LAT ? (MC + b * LL + (rs + t) * 64) : (b * LC + t * 64)); Kt = W_KH + row * DH; Vt = W_VH + row * DH; }
        bf16x8 kf[8];
#pragma unroll
        for (int d0 = 0; d0 < 4; ++d0)
#pragma unroll
            for (int p = 0; p < 2; ++p) kf[2 * d0 + p] = *(const GAS bf16x8*)(Kt + (r32 + 32 * p) * DH + 16 * d0 + 8 * hi);
        v4u vr[8];
#pragma unroll
        for (int pc = 0; pc < 8; ++pc) vr[pc] = *(const GAS v4u*)(Vt + ((pc & 3) * 16 + (lane >> 2)) * DH + (pc >> 2) * 32 + (lane & 3) * 8);
        f32x16 p0, p1;
#pragma unroll
        for (int i = 0; i < 16; ++i) { p0[i] = 0.f; p1[i] = 0.f; }
#pragma unroll
        for (int d0 = 0; d0 < 4; ++d0) { p0 = __builtin_amdgcn_mfma_f32_32x32x16_bf16(kf[2 * d0], qr[d0], p0, 0, 0, 0); p1 = __builtin_amdgcn_mfma_f32_32x32x16_bf16(kf[2 * d0 + 1], qr[d0], p1, 0, 0, 0); }
        if (LAT && t < 8) {
            const float* bt = W_BT + ((size_t)(h * 15 + (rs + t - r + 7)) * 64 + qcol) * 64 + 4 * hi;
#pragma unroll
            for (int a = 0; a < 4; ++a) { const f32x4 b0 = *(const GAS f32x4*)(bt + 8 * a), b1 = *(const GAS f32x4*)(bt + 32 + 8 * a);
#pragma unroll
                for (int c = 0; c < 4; ++c) { p0[4 * a + c] += b0[c]; p1[4 * a + c] += b1[c]; } }
        }
#pragma unroll
        for (int pc = 0; pc < 8; ++pc) *(LAS v4u*)(vimg + pc * 1024 + lane * 16) = vr[pc];
        float rm = fmaxf(p0[0], p1[0]);
#pragma unroll
        for (int i = 1; i < 16; ++i) rm = fmaxf(rm, fmaxf(p0[i], p1[i]));
        rm = swap_max(rm);
        const float mn = fmaxf(m_run, rm), alpha = __builtin_amdgcn_exp2f(m_run - mn); m_run = mn;
        float ls = 0.f;
#pragma unroll
        for (int i = 0; i < 16; ++i) { p0[i] = __builtin_amdgcn_exp2f(p0[i] - mn); p1[i] = __builtin_amdgcn_exp2f(p1[i] - mn); ls += p0[i] + p1[i]; }
        l_run = l_run * alpha + ls;
        if (hi == 0) wsf[r32] = alpha;
#pragma unroll
        for (int a = 0; a < 4; ++a) { const f32x4 al = *(const LAS f32x4*)(wsf + 8 * a + 4 * hi);
#pragma unroll
            for (int c = 0; c < 4; ++c) { o0[4 * a + c] *= al[c]; o1[4 * a + c] *= al[c]; } }
        v4u pw[4];
        pw[0] = (v4u){pk2(p0[0], p0[1]), pk2(p0[2], p0[3]), pk2(p0[4], p0[5]), pk2(p0[6], p0[7])};
        pw[1] = (v4u){pk2(p0[8], p0[9]), pk2(p0[10], p0[11]), pk2(p0[12], p0[13]), pk2(p0[14], p0[15])};
        pw[2] = (v4u){pk2(p1[0], p1[1]), pk2(p1[2], p1[3]), pk2(p1[4], p1[5]), pk2(p1[6], p1[7])};
        pw[3] = (v4u){pk2(p1[8], p1[9]), pk2(p1[10], p1[11]), pk2(p1[12], p1[13]), pk2(p1[14], p1[15])};
#pragma unroll
        for (int ks = 0; ks < 4; ++ks) {
            const s16x4 l0 = vtr(vp + ks * 1024), h0 = vtr(vp + ks * 1024 + 512), l1 = vtr(vp + 4096 + ks * 1024), h1 = vtr(vp + 4096 + ks * 1024 + 512);
            const bf16x8 v0 = (bf16x8){l0[0], l0[1], l0[2], l0[3], h0[0], h0[1], h0[2], h0[3]}, v1 = (bf16x8){l1[0], l1[1], l1[2], l1[3], h1[0], h1[1], h1[2], h1[3]};
            const bf16x8 pa = __builtin_bit_cast(bf16x8, pw[ks]);
            o0 = __builtin_amdgcn_mfma_f32_32x32x16_bf16(pa, v0, o0, 0, 0, 0);
            o1 = __builtin_amdgcn_mfma_f32_32x32x16_bf16(pa, v1, o1, 0, 0, 0);
        }
    }
    const float lt = swap_sum(l_run);
    if (hi == 0) wsf[32 + r32] = 1.0f / lt;
    bf16* Ow = W_AO + (size_t)m0 * D + h * DH + r32;
#pragma unroll
    for (int a = 0; a < 4; ++a) { const f32x4 rl = *(const LAS f32x4*)(wsf + 32 + 8 * a + 4 * hi);
#pragma unroll
        for (int c = 0; c < 4; ++c) { const int q = c + 8 * a + 4 * hi;
            Ow[(size_t)q * D] = f2bf(o0[4 * a + c] * rl[c]); Ow[(size_t)q * D + 32] = f2bf(o1[4 * a + c] * rl[c]); } }
    LDS_WAIT(); asm volatile("" ::: "memory");
}

__device__ __forceinline__ f32x4 conv3_4(const bf16* row, int t, int L, float w0, float w1, float w2, float bias) {
    const v2u x = *(const GAS v2u*)(row + t);
    const float xm = t > 0 ? bf1(row[t - 1]) : 0.f, xp = (t + 4 < L) ? bf1(row[t + 4]) : 0.f;
    const float x0 = bflo(x.x), x1 = bfhi(x.x), x2 = bflo(x.y), x3 = bfhi(x.y);
    return (f32x4){w0 * xm + w1 * x0 + w2 * x1 + bias, w0 * x0 + w1 * x1 + w2 * x2 + bias, w0 * x1 + w1 * x2 + w2 * x3 + bias, w0 * x2 + w1 * x3 + w2 * xp + bias};
}
template <int L>
__device__ __forceinline__ void hyena_item(const Frame& F, const Args& A, int c, int m_base) {
    constexpr int TL = 2 * L + 128, LU = L + 112, MT = L / 64, J = (L + 48 + 31) / 32;
    const bf16* KR = (L == LL) ? W_KRL : W_KRC;
    LAS unsigned char* FE = F.wl; LAS unsigned char* UB = F.wl + 4 * TL;
    const int lane = F.lane, i16 = lane & 15, g = lane >> 4, a = i16 >> 2, b = i16 & 3;
    if (lane < 56) { const int row = lane / 14, k = lane % 14, off = k < 6 ? k * 8 : 48 + L + (k - 6) * 8; *(LAS v4u*)(UB + (row * LU + off) * 2) = (v4u){0u, 0u, 0u, 0u}; }
    { const int ch = 1024 + c; const float w0 = A.in[I_HCW][ch], w1 = A.in[I_HCW][HYC + ch], w2 = A.in[I_HCW][2 * HYC + ch], bs = A.in[I_HCB][ch];
      const bf16* vrow = W_HYT + (size_t)ch * M + m_base;
      for (int idx = lane; idx < 4 * L / 8; idx += 64) { const int bb = idx / (L / 8), s = (idx % (L / 8)) * 8; const bf16* src = vrow + bb * L + s;
          const v4u x = *(const GAS v4u*)src; const float xm = s > 0 ? bf1(src[-1]) : 0.f, xp = (s + 8 < L) ? bf1(src[8]) : 0.f;
          float e[10]; e[0] = xm; e[1] = bflo(x.x); e[2] = bfhi(x.x); e[3] = bflo(x.y); e[4] = bfhi(x.y); e[5] = bflo(x.z); e[6] = bfhi(x.z); e[7] = bflo(x.w); e[8] = bfhi(x.w); e[9] = xp;
          float o[8];
#pragma unroll
          for (int k = 0; k < 8; ++k) o[k] = w0 * e[k] + w1 * e[k + 1] + w2 * e[k + 2] + bs;
          *(LAS v4u*)(UB + (bb * LU + 48 + s) * 2) = (v4u){pk2(o[0], o[1]), pk2(o[2], o[3]), pk2(o[4], o[5]), pk2(o[6], o[7])}; } }
    const int x0 = 8 * g - i16 + L + 16;
    const LAS unsigned char* pA = (i16 & 1) ? FE + 2 * TL + 2 * (x0 + 1) : FE + 2 * x0;
    const LAS unsigned char* pB = UB + (b * LU + 16 * a + 8 * g) * 2;
#pragma unroll 1
    for (int order = 0; order < 2; ++order) {
        { const bf16* src = KR + (size_t)((order * 512 + c) * 2) * TL;
          for (int idx = lane; idx < TL / 4; idx += 64) *(LAS v4u*)(FE + idx * 16) = *(const GAS v4u*)(src + idx * 8); }
        f32x4 acc[MT];
#pragma unroll
        for (int mt = 0; mt < MT; ++mt) acc[mt] = (f32x4){0.f, 0.f, 0.f, 0.f};
#pragma unroll 1
        for (int e = -(2 * (MT - 1)); e <= J - 1; ++e) {
            const LAS unsigned* ap = (const LAS unsigned*)(pA + 64 * e);
            const v4u af = (v4u){ap[0], ap[1], ap[2], ap[3]};
            const bf16x8 afr = __builtin_bit_cast(bf16x8, af);
#pragma unroll
            for (int mt = 0; mt < MT; ++mt) { const int j = e + 2 * mt;
                if (j >= 0 && j < J) { const bf16x8 bfr = *(const LAS bf16x8*)(pB + 64 * j);
                    acc[mt] = __builtin_amdgcn_mfma_f32_16x16x32_bf16(afr, bfr, acc[mt], 0, 0, 0); } }
        }
        const int ch = order == 0 ? c : 512 + c;
        const float w0 = A.in[I_HCW][ch], w1 = A.in[I_HCW][HYC + ch], w2 = A.in[I_HCW][2 * HYC + ch], bs = A.in[I_HCB][ch];
        const bf16* xrow = W_HYT + (size_t)ch * M + m_base + b * L;
#pragma unroll
        for (int mt = 0; mt < MT; ++mt) { const int t = 64 * mt + 16 * a + 4 * g;
            const f32x4 xv = conv3_4(xrow, t, L, w0, w1, w2, bs), y = xv * acc[mt];
            const v2u w = (v2u){pk2(y[0], y[1]), pk2(y[2], y[3])};
            if (order == 0) *(LAS v2u*)(UB + (b * LU + 48 + t) * 2) = w;
            else *(GAS v2u*)(W_HYOT + (size_t)c * M + m_base + b * L + t) = w; }
    }
    LDS_WAIT(); asm volatile("" ::: "memory");
}
__device__ __forceinline__ void p2_phase(const Frame& F, const Args& A) {
    constexpr int N_HL = 512, N_AL = 1024, N_AC = 2048, N_HC = 4096, NI = N_HL + N_AL + N_AC + N_HC;
    for (;;) {
        int it = 0; if (F.lane == 0) it = (int)__hip_atomic_fetch_add(W_CTL + CW_Q, 1u, RLX_AGENT);
        it = __builtin_amdgcn_readfirstlane(it);
        if (it >= NI) break;
        if (it < N_HL) { hyena_item<LL>(F, A, it, MC); continue; } it -= N_HL;
        if (it < N_AL) { attn_item<true>(F, A, it); continue; } it -= N_AL;
        if (it < N_AC) { attn_item<false>(F, A, it); continue; } it -= N_AC;
        hyena_item<LC>(F, A, it >> 3, (it & 7) * 1024);
    }
}

__device__ __forceinline__ void p2b_phase(const Frame& F, const Args& A) {
    LAS unsigned char* T = F.lds;
    for (int it = blockIdx.x; it < M / 48; it += F.G) {
        const int m0 = it * 48;
#pragma unroll
        for (int k = 0; k < 6; ++k) { const int idx = F.tid + 512 * k, row = idx / 6, ch = idx % 6;
            *(LAS v4u*)(T + row * 96 + ch * 16) = *(const GAS v4u*)(W_HYOT + (size_t)row * M + m0 + ch * 8); }
        __syncthreads();
        for (int tk = F.wave * 6; tk < F.wave * 6 + 6; ++tk) { const int m = m0 + tk; bf16* arow = W_AO + (size_t)m * D;
            { const v4u x = *(const GAS v4u*)(arow + 8 * F.lane);
              float e[8] = {bflo(x.x), bfhi(x.x), bflo(x.y), bfhi(x.y), bflo(x.z), bfhi(x.z), bflo(x.w), bfhi(x.w)}; float s = 0.f;
#pragma unroll
              for (int k = 0; k < 8; ++k) s += e[k] * e[k];
              const float rs = 1.0f / sqrtf(wave_sum(s) * (1.0f / 512.0f) + EPS);
              const f32x4 g0 = *(const f32x4*)(A.in[I_GNG] + 8 * F.lane), g1 = *(const f32x4*)(A.in[I_GNG] + 8 * F.lane + 4);
              *(GAS v4u*)(arow + 8 * F.lane) = (v4u){pk2(e[0] * rs * g0[0], e[1] * rs * g0[1]), pk2(e[2] * rs * g0[2], e[3] * rs * g0[3]), pk2(e[4] * rs * g1[0], e[5] * rs * g1[1]), pk2(e[6] * rs * g1[2], e[7] * rs * g1[3])}; }
            { float e[8]; float s = 0.f;
#pragma unroll
              for (int k = 0; k < 8; ++k) { e[k] = bf1(*(const LAS unsigned short*)(T + (8 * F.lane + k) * 96 + tk * 2)); s += e[k] * e[k]; }
              const float rs = 1.0f / sqrtf(wave_sum(s) * (1.0f / 512.0f) + EPS);
              const f32x4 g0 = *(const f32x4*)(A.in[I_GNG] + 512 + 8 * F.lane), g1 = *(const f32x4*)(A.in[I_GNG] + 512 + 8 * F.lane + 4);
              *(GAS v4u*)(arow + 512 + 8 * F.lane) = (v4u){pk2(e[0] * rs * g0[0], e[1] * rs * g0[1]), pk2(e[2] * rs * g0[2], e[3] * rs * g0[3]), pk2(e[4] * rs * g1[0], e[5] * rs * g1[1]), pk2(e[6] * rs * g1[2], e[7] * rs * g1[3])}; }
        }
        __syncthreads();
    }
}

__device__ __forceinline__ void p4b_ld(const bf16* up, int rr, f32x4& gg, f32x4& vv, bool ok) {
    if (ok) { const v2u a = *(const GAS v2u*)(up + (long)rr * UPC), b2 = *(const GAS v2u*)(up + (long)rr * UPC + DFF);
        gg = (f32x4){bflo(a.x), bfhi(a.x), bflo(a.y), bfhi(a.y)}; vv = (f32x4){bflo(b2.x), bfhi(b2.x), bflo(b2.y), bfhi(b2.y)}; }
    else { gg = (f32x4){0.f, 0.f, 0.f, 0.f}; vv = gg; }
}
__device__ __forceinline__ void p4b_phase(const Frame& F, const Args& A) {
    const int gw = blockIdx.x * NWAVES + F.wave, NGW = F.G * NWAVES, lane = F.lane;
    for (int it = gw; it < (M / 16) * 11; it += NGW) {
        const int rc = it / 11, cb = it % 11, m0 = rc * 16, col = cb * 256 + lane * 4;
        const int L = m0 < MC ? LC : LL, t0 = m0 < MC ? (m0 & (LC - 1)) : ((m0 - MC) & (LL - 1));
        f32x4 gw0 = *(const f32x4*)(A.in[I_FCW] + col), gw1 = *(const f32x4*)(A.in[I_FCW] + UPC + col), gw2 = *(const f32x4*)(A.in[I_FCW] + 2 * UPC + col), gb = *(const f32x4*)(A.in[I_FCB] + col);
        f32x4 uw0 = *(const f32x4*)(A.in[I_FCW] + DFF + col), uw1 = *(const f32x4*)(A.in[I_FCW] + UPC + DFF + col), uw2 = *(const f32x4*)(A.in[I_FCW] + 2 * UPC + DFF + col), ub = *(const f32x4*)(A.in[I_FCB] + DFF + col);
        const bf16* up = W_U + (size_t)m0 * UPC + col;
        f32x4 gp, gc, gn, vp, vc, vn;
        p4b_ld(up, -1, gp, vp, t0 > 0); p4b_ld(up, 0, gc, vc, true);
#pragma unroll 4
        for (int rr = 0; rr < 16; ++rr) {
            p4b_ld(up, rr + 1, gn, vn, t0 + rr + 1 < L);
            const f32x4 G = gw0 * gp + gw1 * gc + gw2 * gn + gb, V = uw0 * vp + uw1 * vc + uw2 * vn + ub;
            float a[4];
#pragma unroll
            for (int k = 0; k < 4; ++k) a[k] = (G[k] / (1.0f + __expf(-G[k]))) * V[k];
            *(GAS v2u*)(W_ACT + (size_t)(m0 + rr) * DFF + col) = (v2u){pk2(a[0], a[1]), pk2(a[2], a[3])};
            gp = gc; gc = gn; vp = vc; vc = vn;
        }
    }
}

constexpr int N_PHASES = 11;
constexpr int N_LAUNCHES = MK_N_LAUNCHES;
__global__ void __launch_bounds__(NWAVES * 64, 2) fwd_kernel(Args args) {
    extern __shared__ __attribute__((aligned(16))) unsigned char lds[];
    const Args& A = args;
    Frame F;
    F.lds = (LAS unsigned char*)lds;
    F.tid = threadIdx.x; F.lane = F.tid & 63; F.wave = __builtin_amdgcn_readfirstlane(F.tid >> 6); F.G = gridDim.x;
    F.wl = F.lds + F.wave * WAVE_LDS;
    F.ws = args.ws; F.out = args.out;
    volatile LAS unsigned* MISC = (volatile LAS unsigned*)(F.lds + MISC_OFF);
    if (F.tid < 16) MISC[F.tid] = 0u;
    __syncthreads();
    XcdBarrier bar; bar.bar = (unsigned*)(W_CTL + CW_BAR); bar.x = 0; bar.st = nullptr;
    if (N_LAUNCHES == 1) bar = xcd_barrier_post((unsigned*)(W_CTL + CW_BAR), MISC);
    const int lo = args.ph_lo, hi = args.ph_hi;
#define IN(k) (lo <= (k) && (k) < hi)
#define SEAM(k) do { if (IN(k) && IN((k) + 1)) xcd_barrier(bar); } while (0)
    if (IN(0)) { p0a_phase(F, A); } SEAM(0);
    if (IN(1)) { p0b_phase(F, A); } SEAM(1);
    if (IN(2)) {
        { pg8::Gemm g{W_XN, W_WIN, M, QKVC, D}; pg8::StaticOrder S; S.init(M, QKVC, F.G, (int)blockIdx.x);
          EpiQKV E{W_QH, F.out + (size_t)M * D};
          pg8::gemm_phase<EpiQKV, pg8::StaticOrder, true, true>(F.lds, g, S, E); }
        { pg8::Gemm g{W_WIN + (size_t)QKVC * D, W_XN, HYC, M, D}; pg8::StaticOrder S; S.init(HYC, M, F.G, (int)(F.G - 1 - blockIdx.x));
          EpiBf16Plain E{W_HYT, M};
          pg8::gemm_phase<EpiBf16Plain, pg8::StaticOrder, true, true>(F.lds, g, S, E); }
    } SEAM(2);
    if (IN(3)) { p2_phase(F, A); } SEAM(3);
    if (IN(4)) { p2b_phase(F, A); } SEAM(4);
    if (IN(5)) {
        pg8::Gemm g{W_AO, W_WOUT, M, D, D}; pg8::StaticOrder S; S.init(M, D, F.G, (int)blockIdx.x);
        EpiGatedRes E{A.in[I_XP], A.in[I_XS], F.out, W_MODS + 2048};
        pg8::gemm_phase<EpiGatedRes, pg8::StaticOrder, true, true>(F.lds, g, S, E);
    } SEAM(5);
    if (IN(6)) { p3b_phase(F, A); } SEAM(6);
    if (IN(7)) {
        pg8::Gemm g{W_XN, W_WUP, M, UPC, D}; pg8::StaticOrder S; S.init(M, UPC, F.G, (int)blockIdx.x);
        EpiBf16Plain E{W_U, UPC};
        pg8::gemm_phase<EpiBf16Plain, pg8::StaticOrder, true, true>(F.lds, g, S, E);
    } SEAM(7);
    if (IN(8)) { p4b_phase(F, A); } SEAM(8);
    if (IN(9)) {
        pg8::Gemm g{W_ACT, W_WDN, M, D, DFF}; pg8::StaticOrder S; S.init(M, D, F.G, (int)blockIdx.x);
        EpiGatedRes E{nullptr, nullptr, F.out, W_MODS + 5120};
        pg8::gemm_phase<EpiGatedRes, pg8::StaticOrder, true, true>(F.lds, g, S, E);
    } SEAM(9);
    if (IN(10)) { p6_phase(F, A); }
#undef IN
#undef SEAM
}

extern "C" void kernel_launch(void* const* d_in, const int* in_sizes, int n_in, void* d_out, int out_size, void* d_ws, size_t ws_size, hipStream_t stream) {
    static int grid = 0;
    if (grid == 0) {
        if (n_in != 29 || ws_size < WS_END) { fprintf(stderr, "kernel_launch: expected 29 inputs and >= %zu bytes of workspace (got %d, %zu)\n", (size_t)WS_END, n_in, ws_size); grid = -1; return; }
        int dev = 0, cus = 0, per_cu = 0;
        if (hipGetDevice(&dev) != hipSuccess || hipDeviceGetAttribute(&cus, hipDeviceAttributeMultiprocessorCount, dev) != hipSuccess) { grid = -1; return; }
        if (hipFuncSetAttribute((const void*)fwd_kernel, hipFuncAttributeMaxDynamicSharedMemorySize, LDS_BYTES) != hipSuccess) { fprintf(stderr, "kernel_launch: hipFuncSetAttribute failed\n"); grid = -1; return; }
        if (hipOccupancyMaxActiveBlocksPerMultiprocessor(&per_cu, (const void*)fwd_kernel, NWAVES * 64, LDS_BYTES) != hipSuccess || per_cu < 1) { fprintf(stderr, "kernel_launch: occupancy query says %d\n", per_cu); per_cu = 1; }
        (void)hipGetLastError();
        grid = cus * (per_cu > 1 ? 1 : per_cu);
    }
    if (grid < 0) return;
    (void)hipMemsetAsync((char*)d_ws + WS_CTL, 0, CTL_ZERO_BYTES, stream);
    Args a{};
    for (int i = 0; i < 29; ++i) a.in[i] = (const float*)d_in[i];
    a.out = (float*)d_out; a.ws = (unsigned char*)d_ws;
    if (N_LAUNCHES == 1) { a.ph_lo = 0; a.ph_hi = N_PHASES; hipLaunchKernelGGL(fwd_kernel, dim3(grid), dim3(NWAVES * 64), LDS_BYTES, stream, a); }
    else for (int li = 0; li < N_PHASES; ++li) { a.ph_lo = li; a.ph_hi = li + 1; hipLaunchKernelGGL(fwd_kernel, dim3(grid), dim3(NWAVES * 64), LDS_BYTES, stream, a); }
    const hipError_t le = hipPeekAtLastError();
    if (le != hipSuccess) fprintf(stderr, "kernel_launch: launch failed: %s\n", hipGetErrorName(le));
}
```

```cpp
#include <hip/hip_runtime.h>
#include <cstdio>
#include <cstdint>
#ifndef MK_N_LAUNCHES
#define MK_N_LAUNCHES 1
#endif
#ifndef PROBE_DUP
#define PROBE_DUP 0
#endif
#ifndef PROBE_P0A
#define PROBE_P0A 0
#endif
namespace pg8 {
#define PG8_LAS __attribute__((address_space(3)))
typedef unsigned short bf16_t;
typedef short bf16x8 __attribute__((ext_vector_type(8)));
typedef float f32x4 __attribute__((ext_vector_type(4)));
typedef unsigned u32x4 __attribute__((ext_vector_type(4)));
constexpr int BM = 256, BK = 64, HALF = 128, HTB = HALF * BK * 2  , STAGE_BYTES = 8 * HTB, NXCD = 8, WGM = 8;

__host__ __device__ __forceinline__ int lds_byte(int r, int c) { const int st = (r >> 4) * 2 + (c >> 5), rr = r & 15, cc = c & 31, ob = rr * 64 + cc * 2; return st * 1024 + (ob ^ (((ob >> 9) & 1) << 5)); }
__host__ __device__ __forceinline__ void stage_rc(int b, int& R, int& C) { const int st = b / 1024, sb = b % 1024, swz = sb ^ (((sb >> 9) & 1) << 5); R = (st >> 1) * 16 + swz / 64; C = (st & 1) * 32 + (swz % 64) / 2; }
__host__ __device__ __forceinline__ int perm32(int rho) { const int n = rho >> 4, i = rho & 15; return 8 * (i >> 2) + 4 * n + (i & 3); }

struct Unit { int pm, pn; };
struct Gemm { const bf16_t* A; const bf16_t* Bt; int M, N, K; };

struct StaticOrder {
    int nM, nN, nwg, G, c;
    __host__ __device__ void init(int M, int N, int G_, int c_) { nM = M / BM; nN = N / BM; nwg = nM * nN; G = G_; c = c_; }
    __host__ __device__ bool next(int i, Unit& u) const {
        const long L = (long)i * G + c; if (L >= nwg) return false;
        int wgid = (int)L; { const int q = nwg / NXCD, r = nwg % NXCD, xcd = wgid % NXCD, off = wgid / NXCD; wgid = (xcd < r ? xcd * (q + 1) : r * (q + 1) + (xcd - r) * q) + off; }
        const int nig = WGM * nN, gid = wgid / nig, fm = gid * WGM, gsz = (nM - fm) < WGM ? (nM - fm) : WGM;
        u.pm = fm + ((wgid % nig) % gsz); u.pn = (wgid % nig) / gsz; return true;
    }
    __device__ __forceinline__ void a_ready(const Unit&) const {}
    __device__ __forceinline__ void done(const Unit&) const {}
};

__device__ __forceinline__ unsigned cvt_pk_bf16(float lo, float hi) { unsigned r; asm volatile("v_cvt_pk_bf16_f32 %0, %1, %2" : "=v"(r) : "v"(lo), "v"(hi)); return r; }
typedef float f32x2 __attribute__((ext_vector_type(2)));
template <class Epi, class Sched, bool ALIGN_EPI = false, bool SP2 = false>
__device__ __forceinline__ void gemm_phase(PG8_LAS unsigned char* lds, const Gemm g, const Sched& S, const Epi& E) {
    const int tid = threadIdx.x, wid = __builtin_amdgcn_readfirstlane(tid >> 6), lane = tid & 63, wr = wid >> 2, wc = wid & 3, fr = lane & 15, fq = lane >> 4;
    const int K = g.K, nt = K / BK;
    unsigned voffA[2], voffB[2];
#pragma unroll
    for (int i = 0; i < 2; ++i) { int R, C; stage_rc(tid * 16 + i * 8192, R, C); const int Rb = Epi::PERM ? ((R & ~31) + perm32(R & 31)) : R;
        voffA[i] = (unsigned)(R * K + C) * 2u; voffB[i] = (unsigned)(Rb * K + C) * 2u; }
    const size_t kstep = (size_t)(BK * 2);
    const size_t hstep = (size_t)HALF * K * 2;
    const size_t tstep = 2 * hstep;
    const unsigned ldsw = (unsigned)wid * 1024u;
    const int aoff = lds_byte(wr * 64 + fr, fq * 8), boff = lds_byte(wc * 32 + fr, fq * 8);
#define PG8_SA(b, h) (((b) * 2 + (h)) * HTB)
#define PG8_SB(b, h) ((4 + (b) * 2 + (h)) * HTB)
#define PG8_STAGE(bufoff, gbase, voff) do { _Pragma("unroll") for (int _i = 0; _i < 2; ++_i) \
        __builtin_amdgcn_global_load_lds((const unsigned*)((const char*)(gbase) + (voff)[_i]), (PG8_LAS unsigned*)(lds + (bufoff) + ldsw + _i * 8192), 16, 0, 0); } while (0)
#define PG8_LDA(dst, b, h) do { _Pragma("unroll") for (int m = 0; m < 4; ++m) _Pragma("unroll") for (int k = 0; k < 2; ++k) dst[m][k] = *(const PG8_LAS bf16x8*)(lds + PG8_SA(b, h) + aoff + m * 2048 + k * 1024); } while (0)
#define PG8_LDB(dst, b, h) do { _Pragma("unroll") for (int n = 0; n < 2; ++n) _Pragma("unroll") for (int k = 0; k < 2; ++k) dst[n][k] = *(const PG8_LAS bf16x8*)(lds + PG8_SB(b, h) + boff + n * 2048 + k * 1024); } while (0)
#define PG8_MMA(ai, bj, At, Bt) do { __builtin_amdgcn_s_setprio(1); _Pragma("unroll") for (int m = 0; m < 4; ++m) _Pragma("unroll") for (int n = 0; n < 2; ++n) _Pragma("unroll") for (int k = 0; k < 2; ++k) \
        acc[ai][bj][m][n] = __builtin_amdgcn_mfma_f32_16x16x32_bf16(Bt[n][k], At[m][k], acc[ai][bj][m][n], 0, 0, 0); __builtin_amdgcn_s_setprio(0); } while (0)
#define PG8_WAIT_V(n) asm volatile("s_waitcnt vmcnt(" #n ")" ::: "memory")
#define PG8_WAIT_L(n) asm volatile("s_waitcnt lgkmcnt(" #n ")" ::: "memory")
#define PG8_BAR __builtin_amdgcn_s_barrier()
#define PG8_SCHED __builtin_amdgcn_sched_barrier(0)
    Unit cur, nxt; int ui = 0;
    if (!S.next(0, cur)) return;
    f32x4 acc[2][2][4][2];
#pragma unroll
    for (int a = 0; a < 2; ++a)
#pragma unroll
        for (int b = 0; b < 2; ++b)
#pragma unroll
            for (int m = 0; m < 4; ++m)
#pragma unroll
                for (int n = 0; n < 2; ++n) acc[a][b][m][n] = (f32x4){0.f, 0.f, 0.f, 0.f};
    bf16x8 At[4][2], B0[2][2], B1[2][2];
    const char* cA = (const char*)g.A + (size_t)cur.pm * tstep; const char* cB = (const char*)g.Bt + (size_t)cur.pn * tstep;
    S.a_ready(cur);
    if constexpr (SP2) {
        PG8_STAGE(PG8_SB(0, 0), cB, voffB); PG8_STAGE(PG8_SB(0, 1), cB + hstep, voffB); PG8_STAGE(PG8_SA(0, 0), cA, voffA); PG8_STAGE(PG8_SA(0, 1), cA + hstep, voffA);
        if (wr == 1) PG8_BAR;
        PG8_WAIT_V(2); PG8_BAR;
        PG8_STAGE(PG8_SB(1, 0), cB + kstep, voffB); PG8_STAGE(PG8_SA(1, 0), cA + kstep, voffA); PG8_STAGE(PG8_SB(1, 1), cB + hstep + kstep, voffB);
        PG8_WAIT_V(6); PG8_BAR;
    } else {
        PG8_STAGE(PG8_SB(0, 0), cB, voffB); PG8_STAGE(PG8_SA(0, 0), cA, voffA); PG8_STAGE(PG8_SB(0, 1), cB + hstep, voffB); PG8_STAGE(PG8_SA(0, 1), cA + hstep, voffA);
        if (wr == 1) PG8_BAR;
        PG8_WAIT_V(4); PG8_BAR;
        PG8_STAGE(PG8_SB(1, 0), cB + kstep, voffB); PG8_STAGE(PG8_SA(1, 0), cA + kstep, voffA); PG8_STAGE(PG8_SB(1, 1), cB + hstep + kstep, voffB);
        PG8_WAIT_V(6); PG8_BAR;
    }
    for (;;) {
        const bool has_next = S.next(ui + 1, nxt);
        const char* nA = has_next ? (const char*)g.A + (size_t)nxt.pm * tstep : cA; const char* nB = has_next ? (const char*)g.Bt + (size_t)nxt.pn * tstep : cB;
        for (int t = 0; t < nt; t += 2) {
            const bool last = (t == nt - 2);
            const char* a1 = cA + (size_t)(t + 1) * kstep;
            const char* a2 = last ? nA : cA + (size_t)(t + 2) * kstep; const char* b2 = last ? nB : cB + (size_t)(t + 2) * kstep;
            const char* a3 = a2 + kstep; const char* b3 = b2 + kstep;
            if (last && has_next) S.a_ready(nxt);
            if constexpr (SP2) {
            PG8_LDB(B0, 0, 0); PG8_LDB(B1, 0, 1); PG8_SCHED; PG8_LDA(At, 0, 0); PG8_STAGE(PG8_SA(1, 1), a1 + hstep, voffA);
            PG8_WAIT_V(8); PG8_WAIT_L(0); PG8_BAR; PG8_MMA(0, 0, At, B0); PG8_MMA(0, 1, At, B1); PG8_BAR; PG8_SCHED;
            PG8_LDA(At, 0, 1); PG8_STAGE(PG8_SB(0, 0), b2, voffB); PG8_STAGE(PG8_SB(0, 1), b2 + hstep, voffB); PG8_STAGE(PG8_SA(0, 0), a2, voffA);
            PG8_WAIT_V(8); PG8_WAIT_L(0); PG8_BAR; PG8_MMA(1, 0, At, B0); PG8_MMA(1, 1, At, B1); PG8_BAR; PG8_SCHED;
            PG8_LDB(B0, 1, 0); PG8_LDB(B1, 1, 1); PG8_SCHED; PG8_LDA(At, 1, 0); PG8_STAGE(PG8_SA(0, 1), a2 + hstep, voffA);
            PG8_WAIT_V(8); PG8_WAIT_L(0); PG8_BAR; PG8_MMA(0, 0, At, B0); PG8_MMA(0, 1, At, B1); PG8_BAR; PG8_SCHED;
            PG8_LDA(At, 1, 1); PG8_STAGE(PG8_SB(1, 0), b3, voffB); PG8_STAGE(PG8_SB(1, 1), b3 + hstep, voffB); PG8_STAGE(PG8_SA(1, 0), a3, voffA);
            PG8_WAIT_V(8); PG8_WAIT_L(0); PG8_BAR; PG8_MMA(1, 0, At, B0); PG8_MMA(1, 1, At, B1); PG8_BAR; PG8_SCHED;
            } else {
            PG8_LDB(B0, 0, 0); PG8_SCHED; PG8_LDA(At, 0, 0); PG8_STAGE(PG8_SA(1, 1), a1 + hstep, voffA);
            PG8_WAIT_L(8); PG8_BAR; PG8_WAIT_L(0); PG8_MMA(0, 0, At, B0); PG8_BAR; PG8_SCHED;
            PG8_LDB(B1, 0, 1); PG8_STAGE(PG8_SB(0, 0), b2, voffB);
            PG8_BAR; PG8_WAIT_L(0); PG8_MMA(0, 1, At, B1); PG8_BAR;
            PG8_LDA(At, 0, 1); PG8_STAGE(PG8_SA(0, 0), a2, voffA);
            PG8_BAR; PG8_WAIT_L(0); PG8_MMA(1, 0, At, B0); PG8_BAR; PG8_SCHED;
            PG8_STAGE(PG8_SB(0, 1), b2 + hstep, voffB);
            PG8_WAIT_V(6); PG8_BAR; PG8_MMA(1, 1, At, B1); PG8_BAR;
            PG8_LDB(B0, 1, 0); PG8_SCHED; PG8_LDA(At, 1, 0); PG8_STAGE(PG8_SA(0, 1), a2 + hstep, voffA);
            PG8_WAIT_L(8); PG8_BAR; PG8_WAIT_L(0); PG8_MMA(0, 0, At, B0); PG8_BAR; PG8_SCHED;
            PG8_LDB(B1, 1, 1); PG8_STAGE(PG8_SB(1, 0), b3, voffB);
            PG8_BAR; PG8_WAIT_L(0); PG8_MMA(0, 1, At, B1); PG8_BAR;
            PG8_LDA(At, 1, 1); PG8_STAGE(PG8_SA(1, 0), a3, voffA);
            PG8_BAR; PG8_WAIT_L(0); PG8_MMA(1, 0, At, B0); PG8_BAR; PG8_SCHED;
            PG8_STAGE(PG8_SB(1, 1), b3 + hstep, voffB);
            PG8_WAIT_V(6); PG8_BAR; PG8_MMA(1, 1, At, B1); PG8_BAR;
            }
        }
        if constexpr (ALIGN_EPI) { if (wr == 0) PG8_BAR; }
        if constexpr (!Epi::AFTER_DRAIN) { E(acc, cur, wr, wc, fr, fq); S.done(cur); }
        if (!has_next) break;
#pragma unroll
        for (int a = 0; a < 2; ++a)
#pragma unroll
            for (int b = 0; b < 2; ++b)
#pragma unroll
                for (int m = 0; m < 4; ++m)
#pragma unroll
                    for (int n = 0; n < 2; ++n) acc[a][b][m][n] = (f32x4){0.f, 0.f, 0.f, 0.f};
        cur = nxt; cA = nA; cB = nB; ++ui;
        if constexpr (ALIGN_EPI) { if (wr == 1) PG8_BAR; }
    }
    PG8_WAIT_V(0);
    if constexpr (!ALIGN_EPI) { if (wr == 0) PG8_BAR; }
    PG8_BAR;
    if constexpr (Epi::AFTER_DRAIN) { E.fused(acc, cur, wr, wc, fr, fq, lds, wid, lane); S.done(cur); }
#undef PG8_SA
#undef PG8_SB
#undef PG8_STAGE
#undef PG8_LDA
#undef PG8_LDB
#undef PG8_MMA
#undef PG8_WAIT_V
#undef PG8_WAIT_L
#undef PG8_BAR
#undef PG8_SCHED
}
}

constexpr int NWAVES = 8;
constexpr int D = 1024, MC = 8192, ML = 4096, M = MC + ML, LC = 256, LL = 1024;
constexpr int NH = 8, DH = 64, AW = 512, HC = 512, INC = 3072, QKVC = 1536, HYC = 1536, DFF = 2816, UPC = 5632;
constexpr float EPS = 1e-6f;
constexpr float C2 = 0.125f * 1.4426950408889634f;
constexpr float LOG2E = 1.4426950408889634f;
constexpr float MIN_DECAY = -3.0701134573253943f, MAX_DECAY = -15.350567286626973f;
constexpr int TLL = 2 * LL + 128, OFFL = LL + 64, TLC = 2 * LC + 128, OFFC = LC + 64;

constexpr size_t MiB = 1u << 20;
constexpr size_t WS_CTL = 0, CTL_ZERO_BYTES = 64 * 1024;
constexpr size_t WS_MODS = 1 * MiB;
constexpr size_t WS_WIN = 2 * MiB;
constexpr size_t WS_WOUT = 8 * MiB;
constexpr size_t WS_WUP = 10 * MiB;
constexpr size_t WS_WDN = 21 * MiB;
constexpr size_t WS_BT = 27 * MiB;
constexpr size_t WS_KRL = 29 * MiB;
constexpr size_t WS_KRC = 38 * MiB;
constexpr size_t WS_CK = 41 * MiB, WS_CV = 42 * MiB;
constexpr size_t WS_XN = 43 * MiB;
constexpr size_t WS_ACT = 27 * MiB;
constexpr size_t WS_U = 95 * MiB;
constexpr size_t WS_QH = 95 * MiB, WS_KH = 107 * MiB, WS_VH = 119 * MiB;
constexpr size_t WS_HYT = 131 * MiB;
constexpr size_t WS_AO = 167 * MiB;
constexpr size_t WS_HYOT = 191 * MiB;
constexpr size_t WS_END = 227 * MiB;
static_assert(WS_XN + (size_t)M * D * 2 <= WS_U && WS_ACT + (size_t)M * DFF * 2 <= WS_U && WS_U + (size_t)M * UPC * 2 <= WS_END, "ws map");
static_assert(WS_KRL + (size_t)2 * 512 * 2 * TLL * 2 <= WS_KRC && WS_KRC + (size_t)2 * 512 * 2 * TLC * 2 <= WS_CK && WS_BT + (size_t)8 * 15 * 64 * 64 * 4 <= WS_KRL, "ws map 2");
static_assert(WS_WDN + (size_t)D * DFF * 2 <= WS_BT && WS_WUP + (size_t)UPC * D * 2 <= WS_WDN, "ws map 3");
constexpr int CW_Q0 = 256;
constexpr int CW_Q = 64;
constexpr int CW_BAR = 4096;

constexpr int WAVE_LDS = 18432;
constexpr int LDS_BYTES = NWAVES * WAVE_LDS;
constexpr int MISC_OFF = LDS_BYTES - 64;

#define GAS __attribute__((address_space(1)))
#define LAS __attribute__((address_space(3)))
typedef unsigned short bf16;
typedef unsigned v4u __attribute__((ext_vector_type(4)));
typedef unsigned v2u __attribute__((ext_vector_type(2)));
typedef float f32x4 __attribute__((ext_vector_type(4)));
typedef float f32x16 __attribute__((ext_vector_type(16)));
typedef short bf16x8 __attribute__((ext_vector_type(8)));
typedef short s16x4 __attribute__((ext_vector_type(4)));
typedef GAS unsigned gu32;
typedef float f32x2_t __attribute__((ext_vector_type(2))); typedef __bf16 bf16x2_t __attribute__((ext_vector_type(2)));
#define RLX_AGENT __ATOMIC_RELAXED, __HIP_MEMORY_SCOPE_AGENT
#define LDS_WAIT() asm volatile("s_waitcnt lgkmcnt(0)" ::: "memory")
#define VM_WAIT() asm volatile("s_waitcnt vmcnt(0)" ::: "memory")
__device__ __forceinline__ unsigned pk2(float lo, float hi) { f32x2_t v = {lo, hi}; bf16x2_t b = __builtin_convertvector(v, bf16x2_t); return __builtin_bit_cast(unsigned, b); }
__device__ __forceinline__ unsigned short f2bf(float f) { return (unsigned short)(pk2(f, 0.f) & 0xffffu); }
__device__ __forceinline__ float bflo(unsigned u) { return __uint_as_float(u << 16); }
__device__ __forceinline__ float bfhi(unsigned u) { return __uint_as_float(u & 0xffff0000u); }
__device__ __forceinline__ float bf1(unsigned short b) { return __uint_as_float((unsigned)b << 16); }
__device__ __forceinline__ float wave_sum(float v) {
#pragma unroll
    for (int o = 1; o < 64; o <<= 1) v += __shfl_xor(v, o);
    return v;
}
__device__ __forceinline__ float silu_f(float x) { return x / (1.0f + __expf(-x)); }
#define XB_TMO      128
#define XB_XCNT(j)  (256  + 64 * (j))
#define XB_XSUB(j)  (1280 + 64 * (j))
#define XB_XGEN(j)  (2304 + 64 * (j))
#define XB_TOP      3328
#define XB_TOPGEN   3392
#define XCD_BAR_WORDS 3456
#define XB_SPIN_CAP (1u << 18)

__device__ __forceinline__ unsigned xb_ld(unsigned* p)              { return __hip_atomic_load(p, __ATOMIC_RELAXED, __HIP_MEMORY_SCOPE_AGENT); }
__device__ __forceinline__ unsigned xb_add(unsigned* p, unsigned v) { return __hip_atomic_fetch_add(p, v, __ATOMIC_RELAXED, __HIP_MEMORY_SCOPE_AGENT); }
__device__ __forceinline__ unsigned xb_xcc_id() { return (unsigned)__builtin_amdgcn_s_getreg((3 << 11) | 20) & 0xFu; }
#define XB_SPIN(cond, bar) do { unsigned _sp = 0; while (cond) { __builtin_amdgcn_s_sleep(1); \
    if ((++_sp & 255u) == 0u) { if (xb_ld(&(bar)[XB_TMO])) break; if (_sp > XB_SPIN_CAP) { atomicAdd(&(bar)[XB_TMO], 1u); break; } } } } while (0)

struct XcdBarrier {
    unsigned* bar; unsigned x;
    volatile LAS unsigned* st;
};

__device__ __forceinline__ XcdBarrier xcd_barrier_post(unsigned* bar, volatile LAS unsigned* st) {
    XcdBarrier b; b.bar = bar; b.x = xb_xcc_id(); b.st = st;
    if (threadIdx.x == 0) (void)xb_add(&bar[XB_XCNT(b.x)], 1u);
    return b;
}
__device__ __forceinline__ void xcd_barrier_complete(unsigned* bar, unsigned x, unsigned& nloc, unsigned& nx) {
    const unsigned G = gridDim.x * gridDim.y * gridDim.z;
    unsigned sum, cnt, mine, sp = 0u;
    for (;;) {
        sum = 0u; cnt = 0u; mine = 0u;
#pragma unroll
        for (unsigned j = 0; j < 16; ++j) { const unsigned c = xb_ld(&bar[XB_XCNT(j)]); sum += c; cnt += (c > 0u) ? 1u : 0u; mine = (j == x) ? c : mine; }
        if (sum == G) break;
        __builtin_amdgcn_s_sleep(1);
        if ((++sp & 255u) == 0u) { if (xb_ld(&bar[XB_TMO])) break; if (sp > XB_SPIN_CAP) { atomicAdd(&bar[XB_TMO], 1u); break; } }
    }
    nloc = mine > 0u ? mine : 1u; nx = cnt > 0u ? cnt : 1u;
}

__device__ __forceinline__ void xcd_barrier(const XcdBarrier& b) {
    asm volatile("s_waitcnt vmcnt(0)" ::: "memory");
    __syncthreads();
    if (threadIdx.x == 0) {
        unsigned* bar = b.bar;
        __builtin_amdgcn_s_waitcnt(0);
        unsigned nloc = b.st[0], nx = b.st[1];
        if (nloc == 0u) { xcd_barrier_complete(bar, b.x, nloc, nx); b.st[0] = nloc; b.st[1] = nx; }
        const unsigned old = xb_add(&bar[XB_XSUB(b.x)], 1u);
        const unsigned gen = old / nloc;
        if (old + 1u == (gen + 1u) * nloc) {
            __builtin_amdgcn_fence(__ATOMIC_RELEASE, "agent");
            asm volatile("s_waitcnt vmcnt(0)" ::: "memory");
            const unsigned og = xb_add(&bar[XB_TOP], 1u);
            const unsigned tg = og / nx;
            if (og + 1u == (tg + 1u) * nx) xb_add(&bar[XB_TOPGEN], 1u);
            else XB_SPIN(xb_ld(&bar[XB_TOPGEN]) == tg, bar);
            __builtin_amdgcn_fence(__ATOMIC_ACQUIRE, "agent");
            xb_add(&bar[XB_XGEN(b.x)], 1u);
            asm volatile("s_waitcnt vmcnt(0)" ::: "memory");
        } else {
            XB_SPIN(xb_ld(&bar[XB_XGEN(b.x)]) == gen, bar);
            __builtin_amdgcn_fence(__ATOMIC_ACQUIRE, "agent");
            asm volatile("s_waitcnt vmcnt(0)" ::: "memory");
        }
    }
    __syncthreads();
}

struct Args { const float* in[29]; float* out; unsigned char* ws; int ph_lo, ph_hi, qsel, pad; };
static_assert(sizeof(Args) == 31 * 8 + 16, "Args has no padding");
struct Frame {
    LAS unsigned char* lds; LAS unsigned char* wl;
    unsigned char* ws; float* out;
    int tid, lane, wave, G;
};
enum { I_XP = 0, I_XS = 1, I_CK = 2, I_CV = 3, I_C = 4, I_CCTX = 5, I_WADA = 6, I_BADA = 7, I_N1G = 8, I_WIN = 9, I_RPB = 10, I_HCW = 11, I_HCB = 12, I_FW1 = 13, I_FB1 = 14, I_FW2 = 15, I_FB2 = 16,
       I_FW3 = 17, I_FB3 = 18, I_FFREQ = 19, I_FBIAS = 20, I_GNG = 21, I_WOUT = 22, I_N2G = 23, I_WUP = 24, I_FCW = 25, I_FCB = 26, I_WDN = 27, I_FING = 28 };
#define W_CTL   ((gu32*)(F.ws + WS_CTL))
#define W_MODS  ((float*)(F.ws + WS_MODS))
#define W_BT    ((float*)(F.ws + WS_BT))
#define W_WIN   ((bf16*)(F.ws + WS_WIN))
#define W_WOUT  ((bf16*)(F.ws + WS_WOUT))
#define W_WUP   ((bf16*)(F.ws + WS_WUP))
#define W_WDN   ((bf16*)(F.ws + WS_WDN))
#define W_KRL   ((bf16*)(F.ws + WS_KRL))
#define W_KRC   ((bf16*)(F.ws + WS_KRC))
#define W_CK    ((bf16*)(F.ws + WS_CK))
#define W_CV    ((bf16*)(F.ws + WS_CV))
#define W_XN    ((bf16*)(F.ws + WS_XN))
#define W_ACT   ((bf16*)(F.ws + WS_ACT))
#define W_U     ((bf16*)(F.ws + WS_U))
#define W_QH    ((bf16*)(F.ws + WS_QH))
#define W_KH    ((bf16*)(F.ws + WS_KH))
#define W_VH    ((bf16*)(F.ws + WS_VH))
#define W_HYT   ((bf16*)(F.ws + WS_HYT))
#define W_AO    ((bf16*)(F.ws + WS_AO))
#define W_HYOT  ((bf16*)(F.ws + WS_HYOT))
__device__ __forceinline__ const float* xrow_ptr(const float* xp, const float* xs, int m) { return m < MC ? xp + (size_t)m * D : xs + (size_t)(m - MC) * D; }
__device__ __forceinline__ int midx_of(int m) { return m < MC ? 0 : 1 + ((m - MC) >> 10); }

__device__ __forceinline__ void p0_transpose_item(const float* W, int K, int N, bf16* WT, int row_off, LAS float* scr, int item, int lane) {
    const int nblk = N / 32, kb = item / nblk, nb = item % nblk, k0 = 64 * kb, n0 = 32 * nb;
    f32x4 v[8];
#pragma unroll
    for (int i = 0; i < 8; ++i) v[i] = *(const GAS f32x4*)(W + (size_t)(k0 + 8 * i + (lane >> 3)) * N + n0 + (lane & 7) * 4);
#pragma unroll
    for (int i = 0; i < 8; ++i) { LAS float* d = scr + (8 * i + (lane >> 3)) * 33 + (lane & 7) * 4; d[0] = v[i][0]; d[1] = v[i][1]; d[2] = v[i][2]; d[3] = v[i][3]; }
    LDS_WAIT(); asm volatile("" ::: "memory");
    const int c = lane & 7;
#pragma unroll
    for (int j = 0; j < 4; ++j) { const int n = (lane >> 3) + 8 * j; const LAS float* s = scr + (8 * c) * 33 + n;
        v4u o; o.x = pk2(s[0 * 33], s[1 * 33]); o.y = pk2(s[2 * 33], s[3 * 33]); o.z = pk2(s[4 * 33], s[5 * 33]); o.w = pk2(s[6 * 33], s[7 * 33]);
        *(GAS v4u*)(WT + (size_t)(row_off + n0 + n) * K + k0 + 8 * c) = o; }
    LDS_WAIT(); asm volatile("" ::: "memory");
}
__device__ __forceinline__ void adaln_block(const Frame& F, const Args& A, int it) {
    const int col0 = 32 * it, w = F.wave, lane = F.lane, sub = lane >> 3, c4 = (lane & 7) * 4;
    float acc[5][4];
#pragma unroll
    for (int v = 0; v < 5; ++v)
#pragma unroll
        for (int e = 0; e < 4; ++e) acc[v][e] = 0.f;
    const float* wa = A.in[I_WADA] + col0 + c4;
#pragma unroll 4
    for (int j = 0; j < 16; ++j) {
        const int k = 128 * w + 8 * j + sub;
        const f32x4 wv = *(const GAS f32x4*)(wa + (size_t)k * 6144);
        float s[5]; s[0] = silu_f(A.in[I_CCTX][k]);
#pragma unroll
        for (int v = 1; v < 5; ++v) s[v] = silu_f(A.in[I_C][(v - 1) * D + k]);
#pragma unroll
        for (int v = 0; v < 5; ++v)
#pragma unroll
            for (int e = 0; e < 4; ++e) acc[v][e] += s[v] * wv[e];
    }
#pragma unroll
    for (int v = 0; v < 5; ++v)
#pragma unroll
        for (int e = 0; e < 4; ++e) { float a = acc[v][e]; a += __shfl_xor(a, 8); a += __shfl_xor(a, 16); a += __shfl_xor(a, 32); acc[v][e] = a; }
    LAS float* red = (LAS float*)F.lds;
    if (lane < 8) {
#pragma unroll
        for (int v = 0; v < 5; ++v)
#pragma unroll
            for (int e = 0; e < 4; ++e) red[(w * 5 + v) * 32 + c4 + e] = acc[v][e];
    }
    __syncthreads();
    if (F.tid < 160) { const int v = F.tid >> 5, cc = F.tid & 31; float s = 0.f;
#pragma unroll
        for (int w8 = 0; w8 < 8; ++w8) s += red[(w8 * 5 + v) * 32 + cc];
        W_MODS[v * 6144 + col0 + cc] = s + A.in[I_BADA][col0 + cc]; }
    __syncthreads();
}
__device__ __forceinline__ void filter_item(const Frame& F, const Args& A, int it) {
    const int pc = it >> 3, cc = it & 7, lane = F.lane;
    LAS float* zb = (LAS float*)F.wl;
    LAS float* h1 = (LAS float*)(F.wl + 1280);
    LAS float* h2 = (LAS float*)(F.wl + 1280 + 4096);
    for (int pp = 0; pp < 16; ++pp) {
        const int p = pc * 16 + pp; const float t = (float)p * (1.0f / 1024.0f);
        float val = t;
        if (lane >= 1 && lane <= 16) { const int f = (lane - 1) & 7; const float ang = (6.283185307179586f * t) * (float)(f + 1); val = (lane <= 8) ? cosf(ang) : sinf(ang); }
        if (lane < 17) zb[pp * 20 + lane] = val;
    }
    LDS_WAIT(); asm volatile("" ::: "memory");
    const float fq = A.in[I_FFREQ][lane];
    { float w1c[17];
#pragma unroll
      for (int e = 0; e < 17; ++e) w1c[e] = A.in[I_FW1][e * 64 + lane];
      const float b1v = A.in[I_FB1][lane];
      for (int pp = 0; pp < 16; ++pp) { float s = b1v;
#pragma unroll
          for (int e = 0; e < 17; ++e) s += zb[pp * 20 + e] * w1c[e];
          h1[pp * 64 + lane] = sinf(fq * s); } }
    LDS_WAIT(); asm volatile("" ::: "memory");
    { float w2c[64];
#pragma unroll
      for (int i = 0; i < 64; ++i) w2c[i] = A.in[I_FW2][i * 64 + lane];
      const float b2v = A.in[I_FB2][lane];
      for (int pp = 0; pp < 16; ++pp) { float s = b2v;
#pragma unroll
          for (int i = 0; i < 64; i += 4) { const f32x4 hv = *(const LAS f32x4*)(h1 + pp * 64 + i); s += hv[0] * w2c[i] + hv[1] * w2c[i + 1] + hv[2] * w2c[i + 2] + hv[3] * w2c[i + 3]; }
          h2[lane * 16 + pp] = sinf(fq * s); } }
    LDS_WAIT(); asm volatile("" ::: "memory");
    float acc[16][4];
#pragma unroll
    for (int pp = 0; pp < 16; ++pp)
#pragma unroll
        for (int q = 0; q < 4; ++q) acc[pp][q] = 0.f;
    const float* w3p = A.in[I_FW3] + cc * 256 + lane;
#pragma unroll 2
    for (int j = 0; j < 64; ++j) {
        float w3v[4];
#pragma unroll
        for (int q = 0; q < 4; ++q) w3v[q] = w3p[(size_t)j * 2048 + q * 64];
        float hv[16];
#pragma unroll
        for (int k = 0; k < 4; ++k) { const f32x4 t4 = *(const LAS f32x4*)(h2 + j * 16 + 4 * k); hv[4 * k] = t4[0]; hv[4 * k + 1] = t4[1]; hv[4 * k + 2] = t4[2]; hv[4 * k + 3] = t4[3]; }
#pragma unroll
        for (int pp = 0; pp < 16; ++pp)
#pragma unroll
            for (int q = 0; q < 4; ++q) acc[pp][q] += hv[pp] * w3v[q];
    }
#pragma unroll
    for (int q = 0; q < 4; ++q) {
        const int col = cc * 256 + q * 64 + lane, o = col >> 10, dir = (col >> 9) & 1, c = col & 511;
        const float b3v = A.in[I_FB3][col];
        const float delta = fabsf(MIN_DECAY + (MAX_DECAY - MIN_DECAY) * ((float)c / 511.0f));
        const float fb = dir == 0 ? A.in[I_FBIAS][o * 512 + c] : 0.f;
        bf16* rowL = W_KRL + (size_t)((o * 512 + c) * 2) * TLL;
        bf16* rowC = W_KRC + (size_t)((o * 512 + c) * 2) * TLC;
#pragma unroll
        for (int pp = 0; pp < 16; ++pp) {
            const int p = pc * 16 + pp; const float t = (float)p * (1.0f / 1024.0f);
            float val = (acc[pp][q] + b3v) * expf(-t * delta);
            if (p == 0) val += fb;
            if (dir == 0 || p > 0) {
                const unsigned short bv = f2bf(val);
                const int idx = dir ? OFFL + p : OFFL - p;
                rowL[idx] = bv; rowL[TLL + idx + 1] = bv;
                if ((p & 3) == 0) { const int P = p >> 2, idc = dir ? OFFC + P : OFFC - P; rowC[idc] = bv; rowC[TLC + idc + 1] = bv; }
            }
        }
    }
    LDS_WAIT(); asm volatile("" ::: "memory");
}
__device__ __forceinline__ void krpad_item(const Frame& F, const Args& A, int zi) {
    const int type = zi >> 11, row = zi & 2047, copy = row & 1, lane = F.lane;
    const int L = type ? LC : LL, TL = 2 * L + 128;
    bf16* base = (type ? W_KRC : W_KRL) + (size_t)row * TL;
    for (int idx = lane; idx < 66; idx += 64) if (idx < 65 + copy) base[idx] = 0;
    { const int idx = 2 * L + 64 + lane; if (idx >= 2 * L + 64 + copy) base[idx] = 0; }
}
__device__ __forceinline__ void bias_item(const Frame& F, const Args& A, int it) {
    const float* rp = A.in[I_RPB] + (size_t)it * 31; float* dst = W_BT + (size_t)it * 4096;
    for (int k = 0; k < 64; ++k) { const int e = F.lane + 64 * k, qcol = e >> 6, kcol = e & 63;
        int cs = qcol - 8; cs = cs < 0 ? 0 : (cs > 48 ? 48 : cs);
        const bool valid = kcol >= cs && kcol < cs + 16;
        int dc = kcol - qcol; dc = dc < -15 ? -15 : (dc > 15 ? 15 : dc);
        dst[e] = valid ? rp[dc + 15] * LOG2E : -1e30f; }
}
__device__ __forceinline__ void ckv_item(const Frame& F, const Args& A, int it) {
    const float* src = (it < 1024 ? A.in[I_CK] : A.in[I_CV]) + (size_t)(it & 1023) * 512 + F.lane * 8;
    bf16* dst = (it < 1024 ? W_CK : W_CV) + (size_t)(it & 1023) * 512 + F.lane * 8;
    const f32x4 a = *(const GAS f32x4*)src, b = *(const GAS f32x4*)(src + 4);
    v4u o; o.x = pk2(a[0], a[1]); o.y = pk2(a[2], a[3]); o.z = pk2(b[0], b[1]); o.w = pk2(b[2], b[3]);
    *(GAS v4u*)dst = o;
}
__device__ __forceinline__ void p0a_phase(const Frame& F, const Args& A) {
    for (int rep = 0; rep < 1 + ((PROBE_P0A >> 3) & 1); ++rep)
    for (int it = blockIdx.x; it < 192; it += F.G) adaln_block(F, A, it);
    constexpr int I_F = 512, I_IN = (D / 64) * (INC / 32), I_OUT = (D / 64) * (D / 32), I_UP = (D / 64) * (UPC / 32), I_DN = (DFF / 64) * (D / 32), I_PAD = 4096, I_BT = 120, I_CKV = 2048;
    constexpr int XF = 1 + (PROBE_P0A & 1), XT = 1 + ((PROBE_P0A >> 1) & 1), XS = 1 + ((PROBE_P0A >> 2) & 1);
    constexpr int E_F = XF * I_F, E_IN = E_F + XT * I_IN, E_UP = E_IN + XT * I_UP, E_DN = E_UP + XT * I_DN, E_OUT = E_DN + XT * I_OUT, E_BT = E_OUT + XS * I_BT, E_PAD = E_BT + XS * I_PAD / 8, E_CKV = E_PAD + XS * I_CKV / 8;
    LAS float* scr = (LAS float*)F.wl;
    LAS unsigned* qc = (LAS unsigned*)(F.lds + MISC_OFF) + 8;
    int it = 0;
#define P0A_NEXT() do { it = 0; if (F.lane == 0) it = (int)__hip_atomic_fetch_add(qc, 1u, __ATOMIC_RELAXED, __HIP_MEMORY_SCOPE_WORKGROUP); it = __builtin_amdgcn_readfirstlane(it) * F.G + (int)blockIdx.x; } while (0)
    P0A_NEXT();
#pragma unroll 1
    while (it < E_F) { filter_item(F, A, it % I_F); P0A_NEXT(); }
#pragma unroll 1
    while (it < E_IN) { p0_transpose_item(A.in[I_WIN], D, INC, W_WIN, 0, scr, (it - E_F) % I_IN, F.lane); P0A_NEXT(); }
#pragma unroll 1
    while (it < E_UP) { p0_transpose_item(A.in[I_WUP], D, UPC, W_WUP, 0, scr, (it - E_IN) % I_UP, F.lane); P0A_NEXT(); }
#pragma unroll 1
    while (it < E_DN) { p0_transpose_item(A.in[I_WDN], DFF, D, W_WDN, 0, scr, (it - E_UP) % I_DN, F.lane); P0A_NEXT(); }
#pragma unroll 1
    while (it < E_OUT) { p0_transpose_item(A.in[I_WOUT], D, D, W_WOUT, 0, scr, (it - E_DN) % I_OUT, F.lane); P0A_NEXT(); }
#pragma unroll 1
    while (it < E_BT) { bias_item(F, A, (it - E_OUT) % I_BT); P0A_NEXT(); }
#pragma unroll 1
    while (it < E_PAD) { for (int k = 0; k < 8; ++k) krpad_item(F, A, ((it - E_BT) * 8 + k) % I_PAD); P0A_NEXT(); }
#pragma unroll 1
    while (it < E_CKV) { for (int k = 0; k < 8; ++k) ckv_item(F, A, ((it - E_PAD) * 8 + k) % I_CKV); P0A_NEXT(); }
#undef P0A_NEXT
}

__device__ __forceinline__ void norm_mod_row(const float* xrow, const float* g, const float* sc, const float* sh, bf16* orow, int lane) {
    const GAS f32x4* xr = (const GAS f32x4*)xrow + lane;
    f32x4 v[4]; float s = 0.f;
#pragma unroll
    for (int j = 0; j < 4; ++j) { v[j] = xr[64 * j]; s += (v[j][0] * v[j][0] + v[j][1] * v[j][1]) + (v[j][2] * v[j][2] + v[j][3] * v[j][3]); }
    const float rs = 1.0f / sqrtf(wave_sum(s) * (1.0f / D) + EPS);
    GAS v2u* o8 = (GAS v2u*)orow + lane;
#pragma unroll
    for (int j = 0; j < 4; ++j) { const int col = 4 * lane + 256 * j;
        const f32x4 g4 = *(const f32x4*)(g + col), s4 = *(const f32x4*)(sc + col), h4 = *(const f32x4*)(sh + col);
        const f32x4 y = (v[j] * rs) * g4 * (s4 + 1.0f) + h4;
        v2u w; w.x = pk2(y[0], y[1]); w.y = pk2(y[2], y[3]); o8[64 * j] = w; }
}
__device__ __forceinline__ void p0b_phase(const Frame& F, const Args& A) {
    const int gw = blockIdx.x * NWAVES + F.wave, NGW = F.G * NWAVES;
    for (int m = gw; m < M; m += NGW) { const float* md = W_MODS + midx_of(m) * 6144;
        norm_mod_row(xrow_ptr(A.in[I_XP], A.in[I_XS], m), A.in[I_N1G], md + 1024, md, W_XN + (size_t)m * D, F.lane); }
}
__device__ __forceinline__ void p3b_phase(const Frame& F, const Args& A) {
    const int gw = blockIdx.x * NWAVES + F.wave, NGW = F.G * NWAVES;
    for (int m = gw; m < M; m += NGW) { const float* md = W_MODS + midx_of(m) * 6144;
        norm_mod_row(F.out + (size_t)m * D, A.in[I_N2G], md + 4096, md + 3072, W_XN + (size_t)m * D, F.lane); }
}
__device__ __forceinline__ void p6_phase(const Frame& F, const Args& A) {
    const int gw = blockIdx.x * NWAVES + F.wave, NGW = F.G * NWAVES;
    for (int m = gw; m < M; m += NGW) {
        GAS f32x4* xr = (GAS f32x4*)(F.out + (size_t)m * D) + F.lane;
        f32x4 v[4]; float s = 0.f;
#pragma unroll
        for (int j = 0; j < 4; ++j) { v[j] = xr[64 * j]; s += (v[j][0] * v[j][0] + v[j][1] * v[j][1]) + (v[j][2] * v[j][2] + v[j][3] * v[j][3]); }
        const float rs = 1.0f / sqrtf(wave_sum(s) * (1.0f / D) + EPS);
#pragma unroll
        for (int j = 0; j < 4; ++j) { const f32x4 g4 = *(const f32x4*)(A.in[I_FING] + 4 * F.lane + 256 * j); xr[64 * j] = (v[j] * rs) * g4; }
    }
}

struct EpiQKV {
    static constexpr bool PERM = true, AFTER_DRAIN = false;
    bf16* QH; float* state_k;
    __device__ __forceinline__ void operator()(const pg8::f32x4 (&acc)[2][2][4][2], const pg8::Unit& u, int wr, int wc, int fr, int fq) const {
        const int which = u.pn >> 1; const float sc = which == 0 ? C2 : 1.0f;
        bf16* dstb = QH + (size_t)which * ((size_t)NH * M * DH);
        float* st = state_k + (size_t)(which == 2 ? 1 : 0) * ((size_t)32 * NH * LC * DH);
#pragma unroll
        for (int ai = 0; ai < 2; ++ai)
#pragma unroll
            for (int m = 0; m < 4; ++m) { const int row = u.pm * 256 + ai * 128 + wr * 64 + m * 16 + fr;
#pragma unroll
                for (int bj = 0; bj < 2; ++bj) { const int hc = (u.pn & 1) * 256 + bj * 128 + wc * 32 + 8 * fq, h = hc >> 6, d = hc & 63;
                    const f32x4 v0 = acc[ai][bj][m][0] * sc, v1 = acc[ai][bj][m][1] * sc;
                    v4u w; w.x = pk2(v0[0], v0[1]); w.y = pk2(v0[2], v0[3]); w.z = pk2(v1[0], v1[1]); w.w = pk2(v1[2], v1[3]);
                    *(GAS v4u*)(dstb + ((size_t)h * M + row) * DH + d) = w;
                    if (which != 0 && row < MC) { float* sp = st + ((size_t)((row >> 8) * NH + h) * LC + (row & 255)) * DH + d;
                        *(GAS f32x4*)sp = v0; *(GAS f32x4*)(sp + 4) = v1; } } }
    }
};
struct EpiBf16Plain {
    static constexpr bool PERM = true, AFTER_DRAIN = false;
    bf16* O; int ldc;
    __device__ __forceinline__ void operator()(const pg8::f32x4 (&acc)[2][2][4][2], const pg8::Unit& u, int wr, int wc, int fr, int fq) const {
#pragma unroll
        for (int ai = 0; ai < 2; ++ai)
#pragma unroll
            for (int m = 0; m < 4; ++m) { bf16* rowp = O + (size_t)(u.pm * 256 + ai * 128 + wr * 64 + m * 16 + fr) * ldc + u.pn * 256 + wc * 32 + 8 * fq;
#pragma unroll
                for (int bj = 0; bj < 2; ++bj) { const f32x4 v0 = acc[ai][bj][m][0], v1 = acc[ai][bj][m][1];
                    v4u w; w.x = pk2(v0[0], v0[1]); w.y = pk2(v0[2], v0[3]); w.z = pk2(v1[0], v1[1]); w.w = pk2(v1[2], v1[3]);
                    *(GAS v4u*)(rowp + bj * 128) = w; } }
    }
};
struct EpiGatedRes {
    static constexpr bool PERM = false, AFTER_DRAIN = false;
    const float* xp; const float* xs; float* out; const float* gate;
    __device__ __forceinline__ void operator()(const pg8::f32x4 (&acc)[2][2][4][2], const pg8::Unit& u, int wr, int wc, int fr, int fq) const {
        const int row00 = u.pm * 256; const float* gt = gate + midx_of(row00) * 6144;
        const int col0 = u.pn * 256 + wc * 32 + 4 * fq;
        f32x4 gv[2][2];
#pragma unroll
        for (int bj = 0; bj < 2; ++bj)
#pragma unroll
            for (int n = 0; n < 2; ++n) gv[bj][n] = *(const f32x4*)(gt + col0 + bj * 128 + n * 16);
#pragma unroll
        for (int ai = 0; ai < 2; ++ai)
#pragma unroll
            for (int m = 0; m < 4; ++m) { const int row = row00 + ai * 128 + wr * 64 + m * 16 + fr;
                const float* bp = xp ? (row < MC ? xp + (size_t)row * D : xs + (size_t)(row - MC) * D) : out + (size_t)row * D;
                float* op = out + (size_t)row * D;
#pragma unroll
                for (int bj = 0; bj < 2; ++bj)
#pragma unroll
                    for (int n = 0; n < 2; ++n) { const int c = col0 + bj * 128 + n * 16; const f32x4 bs = *(const GAS f32x4*)(bp + c);
                        *(GAS f32x4*)(op + c) = bs + gv[bj][n] * acc[ai][bj][m][n]; }
                if (m & 1) asm volatile("" ::: "memory"); }
    }
};

__device__ __forceinline__ s16x4 vtr(const LAS unsigned char* p) { typedef short v4i16_t __attribute__((ext_vector_type(4)));
    return __builtin_bit_cast(s16x4, __builtin_amdgcn_ds_read_tr16_b64_v4i16((LAS v4i16_t*)p)); }
__device__ __forceinline__ float swap_max(float m) { auto rr = __builtin_amdgcn_permlane32_swap(__float_as_uint(m), __float_as_uint(m), false, false); return fmaxf(__uint_as_float(rr[0]), __uint_as_float(rr[1])); }
__device__ __forceinline__ float swap_sum(float m) { auto rr = __builtin_amdgcn_permlane32_swap(__float_as_uint(m), __float_as_uint(m), false, false); return __uint_as_float(rr[0]) + __uint_as_float(rr[1]); }
template <bool LAT>
__device__ __forceinline__ void attn_item(const Frame& F, const Args& A, int it) {
    const int lane = F.lane, r32 = lane & 31, hi = lane >> 5;
    int h, b, m0, r = 0, rs = 0, qcol = 0;
    if (LAT) { const int half = it & 1; r = (it >> 1) & 15; h = (it >> 5) & 7; b = it >> 8; m0 = MC + b * LL + r * 64 + half * 32; qcol = half * 32 + r32; rs = r - 4; rs = rs < 0 ? 0 : (rs > 8 ? 8 : rs); }
    else { const int qb = it & 7, bh = it >> 3; b = bh >> 3; h = bh & 7; m0 = b * LC + qb * 32; }
    const bf16* Qw = W_QH + ((size_t)h * M + m0) * DH;
    bf16x8 qr[4];
#pragma unroll
    for (int d0 = 0; d0 < 4; ++d0) qr[d0] = *(const GAS bf16x8*)(Qw + r32 * DH + d0 * 16 + hi * 8);
    float m_run = -1e30f, l_run = 0.f; f32x16 o0, o1;
#pragma unroll
    for (int i = 0; i < 16; ++i) { o0[i] = 0.f; o1[i] = 0.f; }
    LAS unsigned char* vimg = F.wl; LAS float* wsf = (LAS float*)(F.wl + 8192);
    const LAS unsigned char* vp = vimg + ((lane >> 4) & 1) * 32 + (lane & 3) * 8 + (4 * hi + ((lane & 15) >> 2)) * 64;
    constexpr int NT = LAT ? 12 : 4;
    for (int t = 0; t < NT; ++t) {
        const bf16 *Kt, *Vt;
        if (LAT && t >= 8) { const size_t row = (size_t)(b * NH + h) * 256 + (t - 8) * 64; Kt = W_CK + row * DH; Vt = W_CV + row * DH; }
        else { const size_t row = (size_t)h * M + (LAT ? (MC + b * LL + (rs + t) * 64) : (b * LC + t * 64)); Kt = W_KH + row * DH; Vt = W_VH + row * DH; }
        bf16x8 kf[8];
#pragma unroll
        for (int d0 = 0; d0 < 4; ++d0)
#pragma unroll
            for (int p = 0; p < 2; ++p) kf[2 * d0 + p] = *(const GAS bf16x8*)(Kt + (r32 + 32 * p) * DH + 16 * d0 + 8 * hi);
        v4u vr[8];
#pragma unroll
        for (int pc = 0; pc < 8; ++pc) vr[pc] = *(const GAS v4u*)(Vt + ((pc & 3) * 16 + (lane >> 2)) * DH + (pc >> 2) * 32 + (lane & 3) * 8);
        f32x16 p0, p1;
#pragma unroll
        for (int i = 0; i < 16; ++i) { p0[i] = 0.f; p1[i] = 0.f; }
#pragma unroll
        for (int d0 = 0; d0 < 4; ++d0) { p0 = __builtin_amdgcn_mfma_f32_32x32x16_bf16(kf[2 * d0], qr[d0], p0, 0, 0, 0); p1 = __builtin_amdgcn_mfma_f32_32x32x16_bf16(kf[2 * d0 + 1], qr[d0], p1, 0, 0, 0); }
        if (LAT && t < 8) {
            const float* bt = W_BT + ((size_t)(h * 15 + (rs + t - r + 7)) * 64 + qcol) * 64 + 4 * hi;
#pragma unroll
            for (int a = 0; a < 4; ++a) { const f32x4 b0 = *(const GAS f32x4*)(bt + 8 * a), b1 = *(const GAS f32x4*)(bt + 32 + 8 * a);
#pragma unroll
                for (int c = 0; c < 4; ++c) { p0[4 * a + c] += b0[c]; p1[4 * a + c] += b1[c]; } }
        }
#pragma unroll
        for (int pc = 0; pc < 8; ++pc) *(LAS v4u*)(vimg + pc * 1024 + lane * 16) = vr[pc];
        float rm = fmaxf(p0[0], p1[0]);
#pragma unroll
        for (int i = 1; i < 16; ++i) rm = fmaxf(rm, fmaxf(p0[i], p1[i]));
        rm = swap_max(rm);
        const float mn = fmaxf(m_run, rm), alpha = __builtin_amdgcn_exp2f(m_run - mn); m_run = mn;
        float ls = 0.f;
#pragma unroll
        for (int i = 0; i < 16; ++i) { p0[i] = __builtin_amdgcn_exp2f(p0[i] - mn); p1[i] = __builtin_amdgcn_exp2f(p1[i] - mn); ls += p0[i] + p1[i]; }
        l_run = l_run * alpha + ls;
        if (hi == 0) wsf[r32] = alpha;
#pragma unroll
        for (int a = 0; a < 4; ++a) { const f32x4 al = *(const LAS f32x4*)(wsf + 8 * a + 4 * hi);
#pragma unroll
            for (int c = 0; c < 4; ++c) { o0[4 * a + c] *= al[c]; o1[4 * a + c] *= al[c]; } }
        v4u pw[4];
        pw[0] = (v4u){pk2(p0[0], p0[1]), pk2(p0[2], p0[3]), pk2(p0[4], p0[5]), pk2(p0[6], p0[7])};
        pw[1] = (v4u){pk2(p0[8], p0[9]), pk2(p0[10], p0[11]), pk2(p0[12], p0[13]), pk2(p0[14], p0[15])};
        pw[2] = (v4u){pk2(p1[0], p1[1]), pk2(p1[2], p1[3]), pk2(p1[4], p1[5]), pk2(p1[6], p1[7])};
        pw[3] = (v4u){pk2(p1[8], p1[9]), pk2(p1[10], p1[11]), pk2(p1[12], p1[13]), pk2(p1[14], p1[15])};
#pragma unroll
        for (int ks = 0; ks < 4; ++ks) {
            const s16x4 l0 = vtr(vp + ks * 1024), h0 = vtr(vp + ks * 1024 + 512), l1 = vtr(vp + 4096 + ks * 1024), h1 = vtr(vp + 4096 + ks * 1024 + 512);
            const bf16x8 v0 = (bf16x8){l0[0], l0[1], l0[2], l0[3], h0[0], h0[1], h0[2], h0[3]}, v1 = (bf16x8){l1[0], l1[1], l1[2], l1[3], h1[0], h1[1], h1[2], h1[3]};
            const bf16x8 pa = __builtin_bit_cast(bf16x8, pw[ks]);
            o0 = __builtin_amdgcn_mfma_f32_32x32x16_bf16(pa, v0, o0, 0, 0, 0);
            o1 = __builtin_amdgcn_mfma_f32_32x32x16_bf16(pa, v1, o1, 0, 0, 0);
        }
    }
    const float lt = swap_sum(l_run);
    if (hi == 0) wsf[32 + r32] = 1.0f / lt;
    bf16* Ow = W_AO + (size_t)m0 * D + h * DH + r32;
#pragma unroll
    for (int a = 0; a < 4; ++a) { const f32x4 rl = *(const LAS f32x4*)(wsf + 32 + 8 * a + 4 * hi);
#pragma unroll
        for (int c = 0; c < 4; ++c) { const int q = c + 8 * a + 4 * hi;
            Ow[(size_t)q * D] = f2bf(o0[4 * a + c] * rl[c]); Ow[(size_t)q * D + 32] = f2bf(o1[4 * a + c] * rl[c]); } }
    LDS_WAIT(); asm volatile("" ::: "memory");
}

__device__ __forceinline__ f32x4 conv3_4(const bf16* row, int t, int L, float w0, float w1, float w2, float bias) {
    const v2u x = *(const GAS v2u*)(row + t);
    const float xm = t > 0 ? bf1(row[t - 1]) : 0.f, xp = (t + 4 < L) ? bf1(row[t + 4]) : 0.f;
    const float x0 = bflo(x.x), x1 = bfhi(x.x), x2 = bflo(x.y), x3 = bfhi(x.y);
    return (f32x4){w0 * xm + w1 * x0 + w2 * x1 + bias, w0 * x0 + w1 * x1 + w2 * x2 + bias, w0 * x1 + w1 * x2 + w2 * x3 + bias, w0 * x2 + w1 * x3 + w2 * xp + bias};
}
template <int L>
__device__ __forceinline__ void hyena_item(const Frame& F, const Args& A, int c, int m_base) {
    constexpr int TL = 2 * L + 128, LU = L + 112, MT = L / 64, J = (L + 48 + 31) / 32;
    const bf16* KR = (L == LL) ? W_KRL : W_KRC;
    LAS unsigned char* FE = F.wl; LAS unsigned char* UB = F.wl + 4 * TL;
    const int lane = F.lane, i16 = lane & 15, g = lane >> 4, a = i16 >> 2, b = i16 & 3;
    if (lane < 56) { const int row = lane / 14, k = lane % 14, off = k < 6 ? k * 8 : 48 + L + (k - 6) * 8; *(LAS v4u*)(UB + (row * LU + off) * 2) = (v4u){0u, 0u, 0u, 0u}; }
    { const int ch = 1024 + c; const float w0 = A.in[I_HCW][ch], w1 = A.in[I_HCW][HYC + ch], w2 = A.in[I_HCW][2 * HYC + ch], bs = A.in[I_HCB][ch];
      const bf16* vrow = W_HYT + (size_t)ch * M + m_base;
      for (int idx = lane; idx < 4 * L / 8; idx += 64) { const int bb = idx / (L / 8), s = (idx % (L / 8)) * 8; const bf16* src = vrow + bb * L + s;
          const v4u x = *(const GAS v4u*)src; const float xm = s > 0 ? bf1(src[-1]) : 0.f, xp = (s + 8 < L) ? bf1(src[8]) : 0.f;
          float e[10]; e[0] = xm; e[1] = bflo(x.x); e[2] = bfhi(x.x); e[3] = bflo(x.y); e[4] = bfhi(x.y); e[5] = bflo(x.z); e[6] = bfhi(x.z); e[7] = bflo(x.w); e[8] = bfhi(x.w); e[9] = xp;
          float o[8];
#pragma unroll
          for (int k = 0; k < 8; ++k) o[k] = w0 * e[k] + w1 * e[k + 1] + w2 * e[k + 2] + bs;
          *(LAS v4u*)(UB + (bb * LU + 48 + s) * 2) = (v4u){pk2(o[0], o[1]), pk2(o[2], o[3]), pk2(o[4], o[5]), pk2(o[6], o[7])}; } }
    const int x0 = 8 * g - i16 + L + 16;
    const LAS unsigned char* pA = (i16 & 1) ? FE + 2 * TL + 2 * (x0 + 1) : FE + 2 * x0;
    const LAS unsigned char* pB = UB + (b * LU + 16 * a + 8 * g) * 2;
#pragma unroll 1
    for (int order = 0; order < 2; ++order) {
        { const bf16* src = KR + (size_t)((order * 512 + c) * 2) * TL;
          for (int idx = lane; idx < TL / 4; idx += 64) *(LAS v4u*)(FE + idx * 16) = *(const GAS v4u*)(src + idx * 8); }
        f32x4 acc[MT];
#pragma unroll
        for (int mt = 0; mt < MT; ++mt) acc[mt] = (f32x4){0.f, 0.f, 0.f, 0.f};
#pragma unroll 1
        for (int e = -(2 * (MT - 1)); e <= J - 1; ++e) {
            const LAS unsigned* ap = (const LAS unsigned*)(pA + 64 * e);
            const v4u af = (v4u){ap[0], ap[1], ap[2], ap[3]};
            const bf16x8 afr = __builtin_bit_cast(bf16x8, af);
#pragma unroll
            for (int mt = 0; mt < MT; ++mt) { const int j = e + 2 * mt;
                if (j >= 0 && j < J) { const bf16x8 bfr = *(const LAS bf16x8*)(pB + 64 * j);
                    acc[mt] = __builtin_amdgcn_mfma_f32_16x16x32_bf16(afr, bfr, acc[mt], 0, 0, 0); } }
        }
        const int ch = order == 0 ? c : 512 + c;
        const float w0 = A.in[I_HCW][ch], w1 = A.in[I_HCW][HYC + ch], w2 = A.in[I_HCW][2 * HYC + ch], bs = A.in[I_HCB][ch];
        const bf16* xrow = W_HYT + (size_t)ch * M + m_base + b * L;
#pragma unroll
        for (int mt = 0; mt < MT; ++mt) { const int t = 64 * mt + 16 * a + 4 * g;
            const f32x4 xv = conv3_4(xrow, t, L, w0, w1, w2, bs), y = xv * acc[mt];
            const v2u w = (v2u){pk2(y[0], y[1]), pk2(y[2], y[3])};
            if (order == 0) *(LAS v2u*)(UB + (b * LU + 48 + t) * 2) = w;
            else *(GAS v2u*)(W_HYOT + (size_t)c * M + m_base + b * L + t) = w; }
    }
    LDS_WAIT(); asm volatile("" ::: "memory");
}
__device__ __forceinline__ void p2_phase(const Frame& F, const Args& A) {
    LAS unsigned* qc = (LAS unsigned*)(F.lds + MISC_OFF) + 9;
    constexpr int N_HL = 512, N_AL = 1024, N_AC = 2048, N_HC = 4096, NI = N_HL + N_AL + N_AC + N_HC;
    for (;;) {
        int it = 0; if (F.lane == 0) it = (int)__hip_atomic_fetch_add(qc, 1u, __ATOMIC_RELAXED, __HIP_MEMORY_SCOPE_WORKGROUP);
        it = __builtin_amdgcn_readfirstlane(it) * F.G + (int)blockIdx.x;
        if (it >= NI) break;
        if (it < N_HL) { hyena_item<LL>(F, A, it, MC); continue; } it -= N_HL;
        if (it < N_AL) { attn_item<true>(F, A, it); continue; } it -= N_AL;
        if (it < N_AC) { attn_item<false>(F, A, it); continue; } it -= N_AC;
        hyena_item<LC>(F, A, it >> 3, (it & 7) * 1024);
    }
}

__device__ __forceinline__ void p2b_phase(const Frame& F, const Args& A) {
    LAS unsigned char* T = F.lds;
    for (int it = blockIdx.x; it < M / 48; it += F.G) {
        const int m0 = it * 48;
#pragma unroll
        for (int k = 0; k < 6; ++k) { const int idx = F.tid + 512 * k, row = idx / 6, ch = idx % 6;
            *(LAS v4u*)(T + row * 96 + ch * 16) = *(const GAS v4u*)(W_HYOT + (size_t)row * M + m0 + ch * 8); }
        __syncthreads();
        for (int tk = F.wave * 6; tk < F.wave * 6 + 6; ++tk) { const int m = m0 + tk; bf16* arow = W_AO + (size_t)m * D;
            { const v4u x = *(const GAS v4u*)(arow + 8 * F.lane);
              float e[8] = {bflo(x.x), bfhi(x.x), bflo(x.y), bfhi(x.y), bflo(x.z), bfhi(x.z), bflo(x.w), bfhi(x.w)}; float s = 0.f;
#pragma unroll
              for (int k = 0; k < 8; ++k) s += e[k] * e[k];
              const float rs = 1.0f / sqrtf(wave_sum(s) * (1.0f / 512.0f) + EPS);
              const f32x4 g0 = *(const f32x4*)(A.in[I_GNG] + 8 * F.lane), g1 = *(const f32x4*)(A.in[I_GNG] + 8 * F.lane + 4);
              *(GAS v4u*)(arow + 8 * F.lane) = (v4u){pk2(e[0] * rs * g0[0], e[1] * rs * g0[1]), pk2(e[2] * rs * g0[2], e[3] * rs * g0[3]), pk2(e[4] * rs * g1[0], e[5] * rs * g1[1]), pk2(e[6] * rs * g1[2], e[7] * rs * g1[3])}; }
            { float e[8]; float s = 0.f;
#pragma unroll
              for (int k = 0; k < 8; ++k) { e[k] = bf1(*(const LAS unsigned short*)(T + (8 * F.lane + k) * 96 + tk * 2)); s += e[k] * e[k]; }
              const float rs = 1.0f / sqrtf(wave_sum(s) * (1.0f / 512.0f) + EPS);
              const f32x4 g0 = *(const f32x4*)(A.in[I_GNG] + 512 + 8 * F.lane), g1 = *(const f32x4*)(A.in[I_GNG] + 512 + 8 * F.lane + 4);
              *(GAS v4u*)(arow + 512 + 8 * F.lane) = (v4u){pk2(e[0] * rs * g0[0], e[1] * rs * g0[1]), pk2(e[2] * rs * g0[2], e[3] * rs * g0[3]), pk2(e[4] * rs * g1[0], e[5] * rs * g1[1]), pk2(e[6] * rs * g1[2], e[7] * rs * g1[3])}; }
        }
        __syncthreads();
    }
}

__device__ __forceinline__ void p4b_ld(const bf16* up, int rr, f32x4& gg, f32x4& vv, bool ok) {
    if (ok) { const v2u a = *(const GAS v2u*)(up + (long)rr * UPC), b2 = *(const GAS v2u*)(up + (long)rr * UPC + DFF);
        gg = (f32x4){bflo(a.x), bfhi(a.x), bflo(a.y), bfhi(a.y)}; vv = (f32x4){bflo(b2.x), bfhi(b2.x), bflo(b2.y), bfhi(b2.y)}; }
    else { gg = (f32x4){0.f, 0.f, 0.f, 0.f}; vv = gg; }
}
__device__ __forceinline__ void p4b_phase(const Frame& F, const Args& A) {
    const int gw = blockIdx.x * NWAVES + F.wave, NGW = F.G * NWAVES, lane = F.lane;
    for (int it = gw; it < (M / 16) * 11; it += NGW) {
        const int rc = it / 11, cb = it % 11, m0 = rc * 16, col = cb * 256 + lane * 4;
        const int L = m0 < MC ? LC : LL, t0 = m0 < MC ? (m0 & (LC - 1)) : ((m0 - MC) & (LL - 1));
        f32x4 gw0 = *(const f32x4*)(A.in[I_FCW] + col), gw1 = *(const f32x4*)(A.in[I_FCW] + UPC + col), gw2 = *(const f32x4*)(A.in[I_FCW] + 2 * UPC + col), gb = *(const f32x4*)(A.in[I_FCB] + col);
        f32x4 uw0 = *(const f32x4*)(A.in[I_FCW] + DFF + col), uw1 = *(const f32x4*)(A.in[I_FCW] + UPC + DFF + col), uw2 = *(const f32x4*)(A.in[I_FCW] + 2 * UPC + DFF + col), ub = *(const f32x4*)(A.in[I_FCB] + DFF + col);
        const bf16* up = W_U + (size_t)m0 * UPC + col;
        f32x4 gp, gc, gn, vp, vc, vn;
        p4b_ld(up, -1, gp, vp, t0 > 0); p4b_ld(up, 0, gc, vc, true);
#pragma unroll 4
        for (int rr = 0; rr < 16; ++rr) {
            p4b_ld(up, rr + 1, gn, vn, t0 + rr + 1 < L);
            const f32x4 G = gw0 * gp + gw1 * gc + gw2 * gn + gb, V = uw0 * vp + uw1 * vc + uw2 * vn + ub;
            float a[4];
#pragma unroll
            for (int k = 0; k < 4; ++k) a[k] = (G[k] / (1.0f + __expf(-G[k]))) * V[k];
            *(GAS v2u*)(W_ACT + (size_t)(m0 + rr) * DFF + col) = (v2u){pk2(a[0], a[1]), pk2(a[2], a[3])};
            gp = gc; gc = gn; vp = vc; vc = vn;
        }
    }
}

constexpr int N_PHASES = 11;
constexpr int N_LAUNCHES = MK_N_LAUNCHES;
__global__ void __launch_bounds__(NWAVES * 64, 2) fwd_kernel(Args args) {
    extern __shared__ __attribute__((aligned(16))) unsigned char lds[];
    const Args& A = args;
    Frame F;
    F.lds = (LAS unsigned char*)lds;
    F.tid = threadIdx.x; F.lane = F.tid & 63; F.wave = __builtin_amdgcn_readfirstlane(F.tid >> 6); F.G = gridDim.x;
    F.wl = F.lds + F.wave * WAVE_LDS;
    F.ws = args.ws; F.out = args.out;
    volatile LAS unsigned* MISC = (volatile LAS unsigned*)(F.lds + MISC_OFF);
    if (F.tid < 16) MISC[F.tid] = 0u;
    __syncthreads();
    XcdBarrier bar; bar.bar = (unsigned*)(W_CTL + CW_BAR); bar.x = 0; bar.st = nullptr;
    if (N_LAUNCHES == 1) bar = xcd_barrier_post((unsigned*)(W_CTL + CW_BAR), MISC);
    const int lo = args.ph_lo, hi = args.ph_hi;
#define IN(k) (lo <= (k) && (k) < hi)
#define SEAM(k) do { if (IN(k) && IN((k) + 1)) xcd_barrier(bar); } while (0)
    if (IN(0)) { p0a_phase(F, A); } SEAM(0);
    if (IN(1)) { p0b_phase(F, A); } SEAM(1);
    if (IN(2)) {
        { pg8::Gemm g{W_XN, W_WIN, M, QKVC, D}; pg8::StaticOrder S; S.init(M, QKVC, F.G, (int)blockIdx.x);
          EpiQKV E{W_QH, F.out + (size_t)M * D};
          pg8::gemm_phase<EpiQKV, pg8::StaticOrder, true, true>(F.lds, g, S, E); }
        { pg8::Gemm g{W_WIN + (size_t)QKVC * D, W_XN, HYC, M, D}; pg8::StaticOrder S; S.init(HYC, M, F.G, (int)(F.G - 1 - blockIdx.x));
          EpiBf16Plain E{W_HYT, M};
          pg8::gemm_phase<EpiBf16Plain, pg8::StaticOrder, true, true>(F.lds, g, S, E); }
    } SEAM(2);
    if (IN(3)) { p2_phase(F, A); } SEAM(3);
    if (IN(4)) { p2b_phase(F, A); } SEAM(4);
    if (IN(5)) {
        pg8::Gemm g{W_AO, W_WOUT, M, D, D}; pg8::StaticOrder S; S.init(M, D, F.G, (int)blockIdx.x);
        EpiGatedRes E{A.in[I_XP], A.in[I_XS], F.out, W_MODS + 2048};
        pg8::gemm_phase<EpiGatedRes, pg8::StaticOrder, true, true>(F.lds, g, S, E);
    } SEAM(5);
    if (IN(6)) { p3b_phase(F, A); } SEAM(6);
    if (IN(7)) {
        pg8::Gemm g{W_XN, W_WUP, M, UPC, D}; pg8::StaticOrder S; S.init(M, UPC, F.G, (int)blockIdx.x);
        EpiBf16Plain E{W_U, UPC};
        pg8::gemm_phase<EpiBf16Plain, pg8::StaticOrder, true, true>(F.lds, g, S, E);
    } SEAM(7);
    if (IN(8)) { p4b_phase(F, A); } SEAM(8);
    if (IN(9)) {
        pg8::Gemm g{W_ACT, W_WDN, M, D, DFF}; pg8::StaticOrder S; S.init(M, D, F.G, (int)blockIdx.x);
        EpiGatedRes E{nullptr, nullptr, F.out, W_MODS + 5120};
        pg8::gemm_phase<EpiGatedRes, pg8::StaticOrder, true, true>(F.lds, g, S, E);
    } SEAM(9);
    if (IN(10)) { p6_phase(F, A); }
#undef IN
#undef SEAM
}

extern "C" void kernel_launch(void* const* d_in, const int* in_sizes, int n_in, void* d_out, int out_size, void* d_ws, size_t ws_size, hipStream_t stream) {
    static int grid = 0;
    if (grid == 0) {
        if (n_in != 29 || ws_size < WS_END) { fprintf(stderr, "kernel_launch: expected 29 inputs and >= %zu bytes of workspace (got %d, %zu)\n", (size_t)WS_END, n_in, ws_size); grid = -1; return; }
        int dev = 0, cus = 0, per_cu = 0;
        if (hipGetDevice(&dev) != hipSuccess || hipDeviceGetAttribute(&cus, hipDeviceAttributeMultiprocessorCount, dev) != hipSuccess) { grid = -1; return; }
        if (hipFuncSetAttribute((const void*)fwd_kernel, hipFuncAttributeMaxDynamicSharedMemorySize, LDS_BYTES) != hipSuccess) { fprintf(stderr, "kernel_launch: hipFuncSetAttribute failed\n"); grid = -1; return; }
        if (hipOccupancyMaxActiveBlocksPerMultiprocessor(&per_cu, (const void*)fwd_kernel, NWAVES * 64, LDS_BYTES) != hipSuccess || per_cu < 1) { fprintf(stderr, "kernel_launch: occupancy query says %d\n", per_cu); per_cu = 1; }
        (void)hipGetLastError();
        grid = cus * (per_cu > 1 ? 1 : per_cu);
    }
    if (grid < 0) return;
    (void)hipMemsetAsync((char*)d_ws + WS_CTL, 0, CTL_ZERO_BYTES, stream);
    Args a{};
    for (int i = 0; i < 29; ++i) a.in[i] = (const float*)d_in[i];
    a.out = (float*)d_out; a.ws = (unsigned char*)d_ws;
    if (N_LAUNCHES == 1) { a.ph_lo = 0; a.ph_hi = N_PHASES; hipLaunchKernelGGL(fwd_kernel, dim3(grid), dim3(NWAVES * 64), LDS_BYTES, stream, a); }
    else for (int li = 0; li < N_PHASES; ++li) for (int rep = 0; rep < 1 + ((PROBE_DUP >> li) & 1); ++rep) { a.ph_lo = li; a.ph_hi = li + 1; a.qsel = rep; hipLaunchKernelGGL(fwd_kernel, dim3(grid), dim3(NWAVES * 64), LDS_BYTES, stream, a); }
    const hipError_t le = hipPeekAtLastError();
    if (le != hipSuccess) fprintf(stderr, "kernel_launch: launch failed: %s\n", hipGetErrorName(le));
}
```

```cpp
#include <hip/hip_runtime.h>
#include <cstdio>
#include <cstdint>
#ifndef MK_N_LAUNCHES
#define MK_N_LAUNCHES 1
#endif
#ifndef PROBE_DUP
#define PROBE_DUP 0
#endif
#ifndef PROBE_P0A
#define PROBE_P0A 0
#endif
#ifndef PROBE_P2
#define PROBE_P2 0
#endif
namespace pg8 {
#define PG8_LAS __attribute__((address_space(3)))
typedef unsigned short bf16_t;
typedef short bf16x8 __attribute__((ext_vector_type(8)));
typedef float f32x4 __attribute__((ext_vector_type(4)));
typedef unsigned u32x4 __attribute__((ext_vector_type(4)));
constexpr int BM = 256, BK = 64, HALF = 128, HTB = HALF * BK * 2  , STAGE_BYTES = 8 * HTB, NXCD = 8, WGM = 8;

__host__ __device__ __forceinline__ int lds_byte(int r, int c) { const int st = (r >> 4) * 2 + (c >> 5), rr = r & 15, cc = c & 31, ob = rr * 64 + cc * 2; return st * 1024 + (ob ^ (((ob >> 9) & 1) << 5)); }
__host__ __device__ __forceinline__ void stage_rc(int b, int& R, int& C) { const int st = b / 1024, sb = b % 1024, swz = sb ^ (((sb >> 9) & 1) << 5); R = (st >> 1) * 16 + swz / 64; C = (st & 1) * 32 + (swz % 64) / 2; }
__host__ __device__ __forceinline__ int perm32(int rho) { const int n = rho >> 4, i = rho & 15; return 8 * (i >> 2) + 4 * n + (i & 3); }

struct Unit { int pm, pn; };
struct Gemm { const bf16_t* A; const bf16_t* Bt; int M, N, K; };

struct StaticOrder {
    int nM, nN, nwg, G, c;
    __host__ __device__ void init(int M, int N, int G_, int c_) { nM = M / BM; nN = N / BM; nwg = nM * nN; G = G_; c = c_; }
    __host__ __device__ bool next(int i, Unit& u) const {
        const long L = (long)i * G + c; if (L >= nwg) return false;
        int wgid = (int)L; { const int q = nwg / NXCD, r = nwg % NXCD, xcd = wgid % NXCD, off = wgid / NXCD; wgid = (xcd < r ? xcd * (q + 1) : r * (q + 1) + (xcd - r) * q) + off; }
        const int nig = WGM * nN, gid = wgid / nig, fm = gid * WGM, gsz = (nM - fm) < WGM ? (nM - fm) : WGM;
        u.pm = fm + ((wgid % nig) % gsz); u.pn = (wgid % nig) / gsz; return true;
    }
    __device__ __forceinline__ void a_ready(const Unit&) const {}
    __device__ __forceinline__ void done(const Unit&) const {}
};

__device__ __forceinline__ unsigned cvt_pk_bf16(float lo, float hi) { unsigned r; asm volatile("v_cvt_pk_bf16_f32 %0, %1, %2" : "=v"(r) : "v"(lo), "v"(hi)); return r; }
typedef float f32x2 __attribute__((ext_vector_type(2)));
template <class Epi, class Sched, bool ALIGN_EPI = false, bool SP2 = false>
__device__ __forceinline__ void gemm_phase(PG8_LAS unsigned char* lds, const Gemm g, const Sched& S, const Epi& E) {
    const int tid = threadIdx.x, wid = __builtin_amdgcn_readfirstlane(tid >> 6), lane = tid & 63, wr = wid >> 2, wc = wid & 3, fr = lane & 15, fq = lane >> 4;
    const int K = g.K, nt = K / BK;
    unsigned voffA[2], voffB[2];
#pragma unroll
    for (int i = 0; i < 2; ++i) { int R, C; stage_rc(tid * 16 + i * 8192, R, C); const int Rb = Epi::PERM ? ((R & ~31) + perm32(R & 31)) : R;
        voffA[i] = (unsigned)(R * K + C) * 2u; voffB[i] = (unsigned)(Rb * K + C) * 2u; }
    const size_t kstep = (size_t)(BK * 2);
    const size_t hstep = (size_t)HALF * K * 2;
    const size_t tstep = 2 * hstep;
    const unsigned ldsw = (unsigned)wid * 1024u;
    const int aoff = lds_byte(wr * 64 + fr, fq * 8), boff = lds_byte(wc * 32 + fr, fq * 8);
#define PG8_SA(b, h) (((b) * 2 + (h)) * HTB)
#define PG8_SB(b, h) ((4 + (b) * 2 + (h)) * HTB)
#define PG8_STAGE(bufoff, gbase, voff) do { _Pragma("unroll") for (int _i = 0; _i < 2; ++_i) \
        __builtin_amdgcn_global_load_lds((const unsigned*)((const char*)(gbase) + (voff)[_i]), (PG8_LAS unsigned*)(lds + (bufoff) + ldsw + _i * 8192), 16, 0, 0); } while (0)
#define PG8_LDA(dst, b, h) do { _Pragma("unroll") for (int m = 0; m < 4; ++m) _Pragma("unroll") for (int k = 0; k < 2; ++k) dst[m][k] = *(const PG8_LAS bf16x8*)(lds + PG8_SA(b, h) + aoff + m * 2048 + k * 1024); } while (0)
#define PG8_LDB(dst, b, h) do { _Pragma("unroll") for (int n = 0; n < 2; ++n) _Pragma("unroll") for (int k = 0; k < 2; ++k) dst[n][k] = *(const PG8_LAS bf16x8*)(lds + PG8_SB(b, h) + boff + n * 2048 + k * 1024); } while (0)
#define PG8_MMA(ai, bj, At, Bt) do { __builtin_amdgcn_s_setprio(1); _Pragma("unroll") for (int m = 0; m < 4; ++m) _Pragma("unroll") for (int n = 0; n < 2; ++n) _Pragma("unroll") for (int k = 0; k < 2; ++k) \
        acc[ai][bj][m][n] = __builtin_amdgcn_mfma_f32_16x16x32_bf16(Bt[n][k], At[m][k], acc[ai][bj][m][n], 0, 0, 0); __builtin_amdgcn_s_setprio(0); } while (0)
#define PG8_WAIT_V(n) asm volatile("s_waitcnt vmcnt(" #n ")" ::: "memory")
#define PG8_WAIT_L(n) asm volatile("s_waitcnt lgkmcnt(" #n ")" ::: "memory")
#define PG8_BAR __builtin_amdgcn_s_barrier()
#define PG8_SCHED __builtin_amdgcn_sched_barrier(0)
    Unit cur, nxt; int ui = 0;
    if (!S.next(0, cur)) return;
    f32x4 acc[2][2][4][2];
#pragma unroll
    for (int a = 0; a < 2; ++a)
#pragma unroll
        for (int b = 0; b < 2; ++b)
#pragma unroll
            for (int m = 0; m < 4; ++m)
#pragma unroll
                for (int n = 0; n < 2; ++n) acc[a][b][m][n] = (f32x4){0.f, 0.f, 0.f, 0.f};
    bf16x8 At[4][2], B0[2][2], B1[2][2];
    const char* cA = (const char*)g.A + (size_t)cur.pm * tstep; const char* cB = (const char*)g.Bt + (size_t)cur.pn * tstep;
    S.a_ready(cur);
    if constexpr (SP2) {
        PG8_STAGE(PG8_SB(0, 0), cB, voffB); PG8_STAGE(PG8_SB(0, 1), cB + hstep, voffB); PG8_STAGE(PG8_SA(0, 0), cA, voffA); PG8_STAGE(PG8_SA(0, 1), cA + hstep, voffA);
        if (wr == 1) PG8_BAR;
        PG8_WAIT_V(2); PG8_BAR;
        PG8_STAGE(PG8_SB(1, 0), cB + kstep, voffB); PG8_STAGE(PG8_SA(1, 0), cA + kstep, voffA); PG8_STAGE(PG8_SB(1, 1), cB + hstep + kstep, voffB);
        PG8_WAIT_V(6); PG8_BAR;
    } else {
        PG8_STAGE(PG8_SB(0, 0), cB, voffB); PG8_STAGE(PG8_SA(0, 0), cA, voffA); PG8_STAGE(PG8_SB(0, 1), cB + hstep, voffB); PG8_STAGE(PG8_SA(0, 1), cA + hstep, voffA);
        if (wr == 1) PG8_BAR;
        PG8_WAIT_V(4); PG8_BAR;
        PG8_STAGE(PG8_SB(1, 0), cB + kstep, voffB); PG8_STAGE(PG8_SA(1, 0), cA + kstep, voffA); PG8_STAGE(PG8_SB(1, 1), cB + hstep + kstep, voffB);
        PG8_WAIT_V(6); PG8_BAR;
    }
    for (;;) {
        const bool has_next = S.next(ui + 1, nxt);
        const char* nA = has_next ? (const char*)g.A + (size_t)nxt.pm * tstep : cA; const char* nB = has_next ? (const char*)g.Bt + (size_t)nxt.pn * tstep : cB;
        for (int t = 0; t < nt; t += 2) {
            const bool last = (t == nt - 2);
            const char* a1 = cA + (size_t)(t + 1) * kstep;
            const char* a2 = last ? nA : cA + (size_t)(t + 2) * kstep; const char* b2 = last ? nB : cB + (size_t)(t + 2) * kstep;
            const char* a3 = a2 + kstep; const char* b3 = b2 + kstep;
            if (last && has_next) S.a_ready(nxt);
            if constexpr (SP2) {
            PG8_LDB(B0, 0, 0); PG8_LDB(B1, 0, 1); PG8_SCHED; PG8_LDA(At, 0, 0); PG8_STAGE(PG8_SA(1, 1), a1 + hstep, voffA);
            PG8_WAIT_V(8); PG8_WAIT_L(0); PG8_BAR; PG8_MMA(0, 0, At, B0); PG8_MMA(0, 1, At, B1); PG8_BAR; PG8_SCHED;
            PG8_LDA(At, 0, 1); PG8_STAGE(PG8_SB(0, 0), b2, voffB); PG8_STAGE(PG8_SB(0, 1), b2 + hstep, voffB); PG8_STAGE(PG8_SA(0, 0), a2, voffA);
            PG8_WAIT_V(8); PG8_WAIT_L(0); PG8_BAR; PG8_MMA(1, 0, At, B0); PG8_MMA(1, 1, At, B1); PG8_BAR; PG8_SCHED;
            PG8_LDB(B0, 1, 0); PG8_LDB(B1, 1, 1); PG8_SCHED; PG8_LDA(At, 1, 0); PG8_STAGE(PG8_SA(0, 1), a2 + hstep, voffA);
            PG8_WAIT_V(8); PG8_WAIT_L(0); PG8_BAR; PG8_MMA(0, 0, At, B0); PG8_MMA(0, 1, At, B1); PG8_BAR; PG8_SCHED;
            PG8_LDA(At, 1, 1); PG8_STAGE(PG8_SB(1, 0), b3, voffB); PG8_STAGE(PG8_SB(1, 1), b3 + hstep, voffB); PG8_STAGE(PG8_SA(1, 0), a3, voffA);
            PG8_WAIT_V(8); PG8_WAIT_L(0); PG8_BAR; PG8_MMA(1, 0, At, B0); PG8_MMA(1, 1, At, B1); PG8_BAR; PG8_SCHED;
            } else {
            PG8_LDB(B0, 0, 0); PG8_SCHED; PG8_LDA(At, 0, 0); PG8_STAGE(PG8_SA(1, 1), a1 + hstep, voffA);
            PG8_WAIT_L(8); PG8_BAR; PG8_WAIT_L(0); PG8_MMA(0, 0, At, B0); PG8_BAR; PG8_SCHED;
            PG8_LDB(B1, 0, 1); PG8_STAGE(PG8_SB(0, 0), b2, voffB);
            PG8_BAR; PG8_WAIT_L(0); PG8_MMA(0, 1, At, B1); PG8_BAR;
            PG8_LDA(At, 0, 1); PG8_STAGE(PG8_SA(0, 0), a2, voffA);
            PG8_BAR; PG8_WAIT_L(0); PG8_MMA(1, 0, At, B0); PG8_BAR; PG8_SCHED;
            PG8_STAGE(PG8_SB(0, 1), b2 + hstep, voffB);
            PG8_WAIT_V(6); PG8_BAR; PG8_MMA(1, 1, At, B1); PG8_BAR;
            PG8_LDB(B0, 1, 0); PG8_SCHED; PG8_LDA(At, 1, 0); PG8_STAGE(PG8_SA(0, 1), a2 + hstep, voffA);
            PG8_WAIT_L(8); PG8_BAR; PG8_WAIT_L(0); PG8_MMA(0, 0, At, B0); PG8_BAR; PG8_SCHED;
            PG8_LDB(B1, 1, 1); PG8_STAGE(PG8_SB(1, 0), b3, voffB);
            PG8_BAR; PG8_WAIT_L(0); PG8_MMA(0, 1, At, B1); PG8_BAR;
            PG8_LDA(At, 1, 1); PG8_STAGE(PG8_SA(1, 0), a3, voffA);
            PG8_BAR; PG8_WAIT_L(0); PG8_MMA(1, 0, At, B0); PG8_BAR; PG8_SCHED;
            PG8_STAGE(PG8_SB(1, 1), b3 + hstep, voffB);
            PG8_WAIT_V(6); PG8_BAR; PG8_MMA(1, 1, At, B1); PG8_BAR;
            }
        }
        if constexpr (ALIGN_EPI) { if (wr == 0) PG8_BAR; }
        if constexpr (!Epi::AFTER_DRAIN) { E(acc, cur, wr, wc, fr, fq); S.done(cur); }
        if (!has_next) break;
#pragma unroll
        for (int a = 0; a < 2; ++a)
#pragma unroll
            for (int b = 0; b < 2; ++b)
#pragma unroll
                for (int m = 0; m < 4; ++m)
#pragma unroll
                    for (int n = 0; n < 2; ++n) acc[a][b][m][n] = (f32x4){0.f, 0.f, 0.f, 0.f};
        cur = nxt; cA = nA; cB = nB; ++ui;
        if constexpr (ALIGN_EPI) { if (wr == 1) PG8_BAR; }
    }
    PG8_WAIT_V(0);
    if constexpr (!ALIGN_EPI) { if (wr == 0) PG8_BAR; }
    PG8_BAR;
    if constexpr (Epi::AFTER_DRAIN) { E.fused(acc, cur, wr, wc, fr, fq, lds, wid, lane); S.done(cur); }
#undef PG8_SA
#undef PG8_SB
#undef PG8_STAGE
#undef PG8_LDA
#undef PG8_LDB
#undef PG8_MMA
#undef PG8_WAIT_V
#undef PG8_WAIT_L
#undef PG8_BAR
#undef PG8_SCHED
}
}

constexpr int NWAVES = 8;
constexpr int D = 1024, MC = 8192, ML = 4096, M = MC + ML, LC = 256, LL = 1024;
constexpr int NH = 8, DH = 64, AW = 512, HC = 512, INC = 3072, QKVC = 1536, HYC = 1536, DFF = 2816, UPC = 5632;
constexpr float EPS = 1e-6f;
constexpr float C2 = 0.125f * 1.4426950408889634f;
constexpr float LOG2E = 1.4426950408889634f;
constexpr float MIN_DECAY = -3.0701134573253943f, MAX_DECAY = -15.350567286626973f;
constexpr int TLL = 2 * LL + 128, OFFL = LL + 64, TLC = 2 * LC + 128, OFFC = LC + 64;

constexpr size_t MiB = 1u << 20;
constexpr size_t WS_CTL = 0, CTL_ZERO_BYTES = 64 * 1024;
constexpr size_t WS_MODS = 1 * MiB;
constexpr size_t WS_WIN = 2 * MiB;
constexpr size_t WS_WOUT = 8 * MiB;
constexpr size_t WS_WUP = 10 * MiB;
constexpr size_t WS_WDN = 21 * MiB;
constexpr size_t WS_BT = 27 * MiB;
constexpr size_t WS_KRL = 29 * MiB;
constexpr size_t WS_KRC = 38 * MiB;
constexpr size_t WS_CK = 41 * MiB, WS_CV = 42 * MiB;
constexpr size_t WS_XN = 43 * MiB;
constexpr size_t WS_ACT = 27 * MiB;
constexpr size_t WS_U = 95 * MiB;
constexpr size_t WS_QH = 95 * MiB, WS_KH = 107 * MiB, WS_VH = 119 * MiB;
constexpr size_t WS_HYT = 131 * MiB;
constexpr size_t WS_AO = 167 * MiB;
constexpr size_t WS_HYOT = 191 * MiB;
constexpr size_t WS_END = 227 * MiB;
static_assert(WS_XN + (size_t)M * D * 2 <= WS_U && WS_ACT + (size_t)M * DFF * 2 <= WS_U && WS_U + (size_t)M * UPC * 2 <= WS_END, "ws map");
static_assert(WS_KRL + (size_t)2 * 512 * 2 * TLL * 2 <= WS_KRC && WS_KRC + (size_t)2 * 512 * 2 * TLC * 2 <= WS_CK && WS_BT + (size_t)8 * 15 * 64 * 64 * 4 <= WS_KRL, "ws map 2");
static_assert(WS_WDN + (size_t)D * DFF * 2 <= WS_BT && WS_WUP + (size_t)UPC * D * 2 <= WS_WDN, "ws map 3");
constexpr int CW_Q0 = 256;
constexpr int CW_Q = 64;
constexpr int CW_BAR = 4096;

constexpr int WAVE_LDS = 18432;
constexpr int LDS_BYTES = NWAVES * WAVE_LDS;
constexpr int MISC_OFF = LDS_BYTES - 64;

#define GAS __attribute__((address_space(1)))
#define LAS __attribute__((address_space(3)))
typedef unsigned short bf16;
typedef unsigned v4u __attribute__((ext_vector_type(4)));
typedef unsigned v2u __attribute__((ext_vector_type(2)));
typedef float f32x4 __attribute__((ext_vector_type(4)));
typedef float f32x16 __attribute__((ext_vector_type(16)));
typedef short bf16x8 __attribute__((ext_vector_type(8)));
typedef short s16x4 __attribute__((ext_vector_type(4)));
typedef GAS unsigned gu32;
typedef float f32x2_t __attribute__((ext_vector_type(2))); typedef __bf16 bf16x2_t __attribute__((ext_vector_type(2)));
#define RLX_AGENT __ATOMIC_RELAXED, __HIP_MEMORY_SCOPE_AGENT
#define LDS_WAIT() asm volatile("s_waitcnt lgkmcnt(0)" ::: "memory")
#define VM_WAIT() asm volatile("s_waitcnt vmcnt(0)" ::: "memory")
__device__ __forceinline__ unsigned pk2(float lo, float hi) { f32x2_t v = {lo, hi}; bf16x2_t b = __builtin_convertvector(v, bf16x2_t); return __builtin_bit_cast(unsigned, b); }
__device__ __forceinline__ unsigned short f2bf(float f) { return (unsigned short)(pk2(f, 0.f) & 0xffffu); }
__device__ __forceinline__ float bflo(unsigned u) { return __uint_as_float(u << 16); }
__device__ __forceinline__ float bfhi(unsigned u) { return __uint_as_float(u & 0xffff0000u); }
__device__ __forceinline__ float bf1(unsigned short b) { return __uint_as_float((unsigned)b << 16); }
__device__ __forceinline__ float wave_sum(float v) {
#pragma unroll
    for (int o = 1; o < 64; o <<= 1) v += __shfl_xor(v, o);
    return v;
}
__device__ __forceinline__ float silu_f(float x) { return x / (1.0f + __expf(-x)); }
#define XB_TMO      128
#define XB_XCNT(j)  (256  + 64 * (j))
#define XB_XSUB(j)  (1280 + 64 * (j))
#define XB_XGEN(j)  (2304 + 64 * (j))
#define XB_TOP      3328
#define XB_TOPGEN   3392
#define XCD_BAR_WORDS 3456
#define XB_SPIN_CAP (1u << 18)

__device__ __forceinline__ unsigned xb_ld(unsigned* p)              { return __hip_atomic_load(p, __ATOMIC_RELAXED, __HIP_MEMORY_SCOPE_AGENT); }
__device__ __forceinline__ unsigned xb_add(unsigned* p, unsigned v) { return __hip_atomic_fetch_add(p, v, __ATOMIC_RELAXED, __HIP_MEMORY_SCOPE_AGENT); }
__device__ __forceinline__ unsigned xb_xcc_id() { return (unsigned)__builtin_amdgcn_s_getreg((3 << 11) | 20) & 0xFu; }
#define XB_SPIN(cond, bar) do { unsigned _sp = 0; while (cond) { __builtin_amdgcn_s_sleep(1); \
    if ((++_sp & 255u) == 0u) { if (xb_ld(&(bar)[XB_TMO])) break; if (_sp > XB_SPIN_CAP) { atomicAdd(&(bar)[XB_TMO], 1u); break; } } } } while (0)

struct XcdBarrier {
    unsigned* bar; unsigned x;
    volatile LAS unsigned* st;
};

__device__ __forceinline__ XcdBarrier xcd_barrier_post(unsigned* bar, volatile LAS unsigned* st) {
    XcdBarrier b; b.bar = bar; b.x = xb_xcc_id(); b.st = st;
    if (threadIdx.x == 0) (void)xb_add(&bar[XB_XCNT(b.x)], 1u);
    return b;
}
__device__ __forceinline__ void xcd_barrier_complete(unsigned* bar, unsigned x, unsigned& nloc, unsigned& nx) {
    const unsigned G = gridDim.x * gridDim.y * gridDim.z;
    unsigned sum, cnt, mine, sp = 0u;
    for (;;) {
        sum = 0u; cnt = 0u; mine = 0u;
#pragma unroll
        for (unsigned j = 0; j < 16; ++j) { const unsigned c = xb_ld(&bar[XB_XCNT(j)]); sum += c; cnt += (c > 0u) ? 1u : 0u; mine = (j == x) ? c : mine; }
        if (sum == G) break;
        __builtin_amdgcn_s_sleep(1);
        if ((++sp & 255u) == 0u) { if (xb_ld(&bar[XB_TMO])) break; if (sp > XB_SPIN_CAP) { atomicAdd(&bar[XB_TMO], 1u); break; } }
    }
    nloc = mine > 0u ? mine : 1u; nx = cnt > 0u ? cnt : 1u;
}

__device__ __forceinline__ void xcd_barrier(const XcdBarrier& b) {
    asm volatile("s_waitcnt vmcnt(0)" ::: "memory");
    __syncthreads();
    if (threadIdx.x == 0) {
        unsigned* bar = b.bar;
        __builtin_amdgcn_s_waitcnt(0);
        unsigned nloc = b.st[0], nx = b.st[1];
        if (nloc == 0u) { xcd_barrier_complete(bar, b.x, nloc, nx); b.st[0] = nloc; b.st[1] = nx; }
        const unsigned old = xb_add(&bar[XB_XSUB(b.x)], 1u);
        const unsigned gen = old / nloc;
        if (old + 1u == (gen + 1u) * nloc) {
            __builtin_amdgcn_fence(__ATOMIC_RELEASE, "agent");
            asm volatile("s_waitcnt vmcnt(0)" ::: "memory");
            const unsigned og = xb_add(&bar[XB_TOP], 1u);
            const unsigned tg = og / nx;
            if (og + 1u == (tg + 1u) * nx) xb_add(&bar[XB_TOPGEN], 1u);
            else XB_SPIN(xb_ld(&bar[XB_TOPGEN]) == tg, bar);
            __builtin_amdgcn_fence(__ATOMIC_ACQUIRE, "agent");
            xb_add(&bar[XB_XGEN(b.x)], 1u);
            asm volatile("s_waitcnt vmcnt(0)" ::: "memory");
        } else {
            XB_SPIN(xb_ld(&bar[XB_XGEN(b.x)]) == gen, bar);
            __builtin_amdgcn_fence(__ATOMIC_ACQUIRE, "agent");
            asm volatile("s_waitcnt vmcnt(0)" ::: "memory");
        }
    }
    __syncthreads();
}

struct Args { const float* in[29]; float* out; unsigned char* ws; int ph_lo, ph_hi, qsel, pad; };
static_assert(sizeof(Args) == 31 * 8 + 16, "Args has no padding");
struct Frame {
    LAS unsigned char* lds; LAS unsigned char* wl;
    unsigned char* ws; float* out;
    int tid, lane, wave, G;
};
enum { I_XP = 0, I_XS = 1, I_CK = 2, I_CV = 3, I_C = 4, I_CCTX = 5, I_WADA = 6, I_BADA = 7, I_N1G = 8, I_WIN = 9, I_RPB = 10, I_HCW = 11, I_HCB = 12, I_FW1 = 13, I_FB1 = 14, I_FW2 = 15, I_FB2 = 16,
       I_FW3 = 17, I_FB3 = 18, I_FFREQ = 19, I_FBIAS = 20, I_GNG = 21, I_WOUT = 22, I_N2G = 23, I_WUP = 24, I_FCW = 25, I_FCB = 26, I_WDN = 27, I_FING = 28 };
#define W_CTL   ((gu32*)(F.ws + WS_CTL))
#define W_MODS  ((float*)(F.ws + WS_MODS))
#define W_BT    ((float*)(F.ws + WS_BT))
#define W_WIN   ((bf16*)(F.ws + WS_WIN))
#define W_WOUT  ((bf16*)(F.ws + WS_WOUT))
#define W_WUP   ((bf16*)(F.ws + WS_WUP))
#define W_WDN   ((bf16*)(F.ws + WS_WDN))
#define W_KRL   ((bf16*)(F.ws + WS_KRL))
#define W_KRC   ((bf16*)(F.ws + WS_KRC))
#define W_CK    ((bf16*)(F.ws + WS_CK))
#define W_CV    ((bf16*)(F.ws + WS_CV))
#define W_XN    ((bf16*)(F.ws + WS_XN))
#define W_ACT   ((bf16*)(F.ws + WS_ACT))
#define W_U     ((bf16*)(F.ws + WS_U))
#define W_QH    ((bf16*)(F.ws + WS_QH))
#define W_KH    ((bf16*)(F.ws + WS_KH))
#define W_VH    ((bf16*)(F.ws + WS_VH))
#define W_HYT   ((bf16*)(F.ws + WS_HYT))
#define W_AO    ((bf16*)(F.ws + WS_AO))
#define W_HYOT  ((bf16*)(F.ws + WS_HYOT))
__device__ __forceinline__ const float* xrow_ptr(const float* xp, const float* xs, int m) { return m < MC ? xp + (size_t)m * D : xs + (size_t)(m - MC) * D; }
__device__ __forceinline__ int midx_of(int m) { return m < MC ? 0 : 1 + ((m - MC) >> 10); }

__device__ __forceinline__ void adaln_block(const Frame& F, const Args& A, int it) {
    const int col0 = 32 * it, w = F.wave, lane = F.lane, sub = lane >> 3, c4 = (lane & 7) * 4;
    float acc[5][4];
#pragma unroll
    for (int v = 0; v < 5; ++v)
#pragma unroll
        for (int e = 0; e < 4; ++e) acc[v][e] = 0.f;
    const float* wa = A.in[I_WADA] + col0 + c4;
#pragma unroll 4
    for (int j = 0; j < 16; ++j) {
        const int k = 128 * w + 8 * j + sub;
        const f32x4 wv = *(const GAS f32x4*)(wa + (size_t)k * 6144);
        float s[5]; s[0] = silu_f(A.in[I_CCTX][k]);
#pragma unroll
        for (int v = 1; v < 5; ++v) s[v] = silu_f(A.in[I_C][(v - 1) * D + k]);
#pragma unroll
        for (int v = 0; v < 5; ++v)
#pragma unroll
            for (int e = 0; e < 4; ++e) acc[v][e] += s[v] * wv[e];
    }
#pragma unroll
    for (int v = 0; v < 5; ++v)
#pragma unroll
        for (int e = 0; e < 4; ++e) { float a = acc[v][e]; a += __shfl_xor(a, 8); a += __shfl_xor(a, 16); a += __shfl_xor(a, 32); acc[v][e] = a; }
    LAS float* red = (LAS float*)F.lds;
    if (lane < 8) {
#pragma unroll
        for (int v = 0; v < 5; ++v)
#pragma unroll
            for (int e = 0; e < 4; ++e) red[(w * 5 + v) * 32 + c4 + e] = acc[v][e];
    }
    __syncthreads();
    if (F.tid < 160) { const int v = F.tid >> 5, cc = F.tid & 31; float s = 0.f;
#pragma unroll
        for (int w8 = 0; w8 < 8; ++w8) s += red[(w8 * 5 + v) * 32 + cc];
        W_MODS[v * 6144 + col0 + cc] = s + A.in[I_BADA][col0 + cc]; }
    __syncthreads();
}
__device__ __forceinline__ void filter_block(const Frame& F, const Args& A, int it) {
    const int pg = it >> 4, cg = it & 15, lane = F.lane, w = F.wave, p = pg * 64 + lane;
    LAS float* w3s = (LAS float*)F.lds;
    LAS float* zs = (LAS float*)(F.lds + 34816);
    LAS float* h1s = (LAS float*)(F.lds + 39168);
    LAS float* h2s = (LAS float*)(F.lds + 55552);
    LAS float* w2s = (LAS float*)(F.lds + 71936);
    LAS float* w1s = (LAS float*)(F.lds + 89344);
    const float t = (float)p * (1.0f / 1024.0f);
    { const float* w3 = A.in[I_FW3] + cg * 128;
#pragma unroll
      for (int k = 0; k < 16; ++k) { const int e = F.tid + 512 * k, j = e >> 7, c = e & 127; w3s[c * 68 + j] = w3[(size_t)j * 2048 + c]; }
#pragma unroll
      for (int k = 0; k < 8; ++k) { const int e = F.tid + 512 * k, i = e >> 6, j = e & 63; w2s[j * 68 + i] = A.in[I_FW2][e]; }
#pragma unroll
      for (int k = 0; k < 3; ++k) { const int e = F.tid + 512 * k; if (e < 17 * 64) { const int i = e >> 6, j = e & 63; w1s[j * 20 + i] = A.in[I_FW1][e]; } } }
    { const float ang = (6.283185307179586f * t) * (float)(w + 1);
      zs[(1 + w) * 64 + lane] = cosf(ang); zs[(9 + w) * 64 + lane] = sinf(ang); if (w == 0) zs[lane] = t; }
    __syncthreads();
    { float z[17];
#pragma unroll
      for (int e = 0; e < 17; ++e) z[e] = zs[e * 64 + lane];
#pragma unroll 1
      for (int u = 0; u < 8; ++u) { const int j = 8 * w + u; float s = A.in[I_FB1][j]; const LAS float* wr = w1s + j * 20;
#pragma unroll
          for (int e = 0; e < 16; e += 4) { const f32x4 w4 = *(const LAS f32x4*)(wr + e); s += z[e] * w4[0] + z[e + 1] * w4[1] + z[e + 2] * w4[2] + z[e + 3] * w4[3]; }
          s += z[16] * wr[16];
          h1s[j * 64 + lane] = sinf(A.in[I_FFREQ][j] * s); } }
    __syncthreads();
    { float h[64];
#pragma unroll
      for (int i = 0; i < 64; ++i) h[i] = h1s[i * 64 + lane];
#pragma unroll 1
      for (int u = 0; u < 8; ++u) { const int j = 8 * w + u; float s = A.in[I_FB2][j]; const LAS float* wr = w2s + j * 68;
#pragma unroll
          for (int i = 0; i < 64; i += 4) { const f32x4 w4 = *(const LAS f32x4*)(wr + i); s += h[i] * w4[0] + h[i + 1] * w4[1] + h[i + 2] * w4[2] + h[i + 3] * w4[3]; }
          h2s[j * 64 + lane] = sinf(A.in[I_FFREQ][j] * s); } }
    __syncthreads();
    float h[64];
#pragma unroll
    for (int i = 0; i < 64; ++i) h[i] = h2s[i * 64 + lane];
#pragma unroll 1
    for (int q = 0; q < 16; ++q) {
        const int cl = 16 * w + q, col = cg * 128 + cl, o = col >> 10, dir = (col >> 9) & 1, c = col & 511;
        float s = A.in[I_FB3][col];
        const LAS float* wr = w3s + cl * 68;
#pragma unroll
        for (int j = 0; j < 64; j += 4) { const f32x4 w4 = *(const LAS f32x4*)(wr + j); s += h[j] * w4[0] + h[j + 1] * w4[1] + h[j + 2] * w4[2] + h[j + 3] * w4[3]; }
        const float delta = fabsf(MIN_DECAY + (MAX_DECAY - MIN_DECAY) * ((float)c / 511.0f));
        float val = s * expf(-t * delta);
        if (dir == 0 && p == 0) val += A.in[I_FBIAS][o * 512 + c];
        if (dir == 0 || p > 0) {
            const unsigned short bv = f2bf(val);
            bf16* rowL = W_KRL + (size_t)((o * 512 + c) * 2) * TLL;
            const int idx = dir ? OFFL + p : OFFL - p;
            rowL[idx] = bv; rowL[TLL + idx + 1] = bv;
            if ((p & 3) == 0) { bf16* rowC = W_KRC + (size_t)((o * 512 + c) * 2) * TLC; const int P = p >> 2, idc = dir ? OFFC + P : OFFC - P; rowC[idc] = bv; rowC[TLC + idc + 1] = bv; }
        }
    }
    __syncthreads();
}
__device__ __forceinline__ void krpad_item(const Frame& F, const Args& A, int zi) {
    const int type = zi >> 11, row = zi & 2047, copy = row & 1, lane = F.lane;
    const int L = type ? LC : LL, TL = 2 * L + 128;
    bf16* base = (type ? W_KRC : W_KRL) + (size_t)row * TL;
    if (lane < 8) *(GAS v4u*)(base + 8 * lane) = (v4u){0u, 0u, 0u, 0u};
    else if (lane < 15) *(GAS v4u*)(base + 2 * L + 72 + 8 * (lane - 8)) = (v4u){0u, 0u, 0u, 0u};
    else if (lane < 17) { if (lane - 15 <= copy) base[64 + lane - 15] = 0; }
    else if (lane < 25) { const int idx = 2 * L + 64 + (lane - 17); if (idx >= 2 * L + 64 + copy) base[idx] = 0; }
}
__device__ __forceinline__ void bias_item(const Frame& F, const Args& A, int it) {
    const float* rp = A.in[I_RPB] + (size_t)it * 31; float* dst = W_BT + (size_t)it * 4096;
    for (int k = 0; k < 64; ++k) { const int e = F.lane + 64 * k, qcol = e >> 6, kcol = e & 63;
        int cs = qcol - 8; cs = cs < 0 ? 0 : (cs > 48 ? 48 : cs);
        const bool valid = kcol >= cs && kcol < cs + 16;
        int dc = kcol - qcol; dc = dc < -15 ? -15 : (dc > 15 ? 15 : dc);
        dst[e] = valid ? rp[dc + 15] * LOG2E : -1e30f; }
}
__device__ __forceinline__ void ckv_item(const Frame& F, const Args& A, int it) {
    const float* src = (it < 1024 ? A.in[I_CK] : A.in[I_CV]) + (size_t)(it & 1023) * 512 + F.lane * 8;
    bf16* dst = (it < 1024 ? W_CK : W_CV) + (size_t)(it & 1023) * 512 + F.lane * 8;
    const f32x4 a = *(const GAS f32x4*)src, b = *(const GAS f32x4*)(src + 4);
    v4u o; o.x = pk2(a[0], a[1]); o.y = pk2(a[2], a[3]); o.z = pk2(b[0], b[1]); o.w = pk2(b[2], b[3]);
    *(GAS v4u*)dst = o;
}
struct TrItem { const float* W; bf16* WT; int K, N, k0, n0; };
__device__ __forceinline__ bool tr_item(const Frame& F, const Args& A, int t, TrItem& ti) {
    constexpr int B_IN = (D / 64) * (INC / 256), B_UP = (D / 64) * (UPC / 256), B_DN = (DFF / 64) * (D / 256), B_OUT = (D / 64) * (D / 256);
    if (t >= B_IN + B_UP + B_DN + B_OUT) return false;
    int item;
    if (t < B_IN) { ti.W = A.in[I_WIN]; ti.WT = W_WIN; ti.K = D; ti.N = INC; item = t; }
    else if (t < B_IN + B_UP) { ti.W = A.in[I_WUP]; ti.WT = W_WUP; ti.K = D; ti.N = UPC; item = t - B_IN; }
    else if (t < B_IN + B_UP + B_DN) { ti.W = A.in[I_WDN]; ti.WT = W_WDN; ti.K = DFF; ti.N = D; item = t - B_IN - B_UP; }
    else { ti.W = A.in[I_WOUT]; ti.WT = W_WOUT; ti.K = D; ti.N = D; item = t - B_IN - B_UP - B_DN; }
    const int nblk = ti.N / 256; ti.k0 = 64 * (item / nblk); ti.n0 = 256 * (item % nblk); return true;
}
__device__ __forceinline__ void tr_load(const Frame& F, const TrItem& ti, f32x4 (&v)[8]) {
#pragma unroll
    for (int i = 0; i < 8; ++i) v[i] = *(const GAS f32x4*)(ti.W + (size_t)(ti.k0 + 8 * i + F.wave) * ti.N + ti.n0 + F.lane * 4);
}
__device__ __forceinline__ void tr_finish(const Frame& F, const TrItem& ti, const f32x4 (&v)[8]) {
    LAS float* tile = (LAS float*)F.lds;
#pragma unroll
    for (int i = 0; i < 8; ++i) *(LAS f32x4*)(tile + (8 * i + F.wave) * 260 + F.lane * 4) = v[i];
    __syncthreads();
    const int c = F.wave;
#pragma unroll
    for (int q = 0; q < 4; ++q) { const int n = F.lane + 64 * q; const LAS float* s = tile + (8 * c) * 260 + n;
        v4u o; o.x = pk2(s[0 * 260], s[1 * 260]); o.y = pk2(s[2 * 260], s[3 * 260]); o.z = pk2(s[4 * 260], s[5 * 260]); o.w = pk2(s[6 * 260], s[7 * 260]);
        *(GAS v4u*)(ti.WT + (size_t)(ti.n0 + n) * ti.K + ti.k0 + 8 * c) = o; }
    __syncthreads();
}
__device__ __forceinline__ void p0a_phase(const Frame& F, const Args& A) {
    constexpr int NREP = 1 + ((PROBE_P0A >> 1) & 1);
#pragma unroll 1
    for (int rep = 0; rep < NREP; ++rep) {
        if (rep == 0) {
            for (int r2 = 0; r2 < 1 + ((PROBE_P0A >> 3) & 1); ++r2) for (int it = blockIdx.x; it < 192; it += F.G) adaln_block(F, A, it);
            for (int r2 = 0; r2 < 1 + (PROBE_P0A & 1); ++r2) for (int it = blockIdx.x; it < 256; it += F.G) filter_block(F, A, it);
        }
        TrItem ta, tb; f32x4 va[8], vb[8];
        int t = blockIdx.x;
        bool ha = tr_item(F, A, t, ta); if (ha) tr_load(F, ta, va); t += F.G;
        bool hb = tr_item(F, A, t, tb); if (hb) tr_load(F, tb, vb); t += F.G;
#pragma unroll 1
        while (ha || hb) {
            if (ha) { tr_finish(F, ta, va); ha = tr_item(F, A, t, ta); if (ha) tr_load(F, ta, va); t += F.G; }
            if (hb) { tr_finish(F, tb, vb); hb = tr_item(F, A, t, tb); if (hb) tr_load(F, tb, vb); t += F.G; }
        }
    }
    constexpr int I_PAD = 4096, I_BT = 120, I_CKV = 2048;
    constexpr int XS = 1 + ((PROBE_P0A >> 2) & 1);
    constexpr int E_BT = XS * I_BT, E_PAD = E_BT + XS * I_PAD / 8, E_CKV = E_PAD + XS * I_CKV / 8;
    LAS unsigned* qc = (LAS unsigned*)(F.lds + MISC_OFF) + 8;
    int it = 0;
#define P0A_NEXT() do { it = 0; if (F.lane == 0) it = (int)__hip_atomic_fetch_add(qc, 1u, __ATOMIC_RELAXED, __HIP_MEMORY_SCOPE_WORKGROUP); it = __builtin_amdgcn_readfirstlane(it) * F.G + (int)blockIdx.x; } while (0)
    P0A_NEXT();
#pragma unroll 1
    while (it < E_BT) { bias_item(F, A, it % I_BT); P0A_NEXT(); }
#pragma unroll 1
    while (it < E_PAD) { for (int k = 0; k < 8; ++k) krpad_item(F, A, ((it - E_BT) * 8 + k) % I_PAD); P0A_NEXT(); }
#pragma unroll 1
    while (it < E_CKV) { for (int k = 0; k < 8; ++k) ckv_item(F, A, ((it - E_PAD) * 8 + k) % I_CKV); P0A_NEXT(); }
#undef P0A_NEXT
}

__device__ __forceinline__ void norm_mod_row(const float* xrow, const float* g, const float* sc, const float* sh, bf16* orow, int lane) {
    const GAS f32x4* xr = (const GAS f32x4*)xrow + lane;
    f32x4 v[4]; float s = 0.f;
#pragma unroll
    for (int j = 0; j < 4; ++j) { v[j] = xr[64 * j]; s += (v[j][0] * v[j][0] + v[j][1] * v[j][1]) + (v[j][2] * v[j][2] + v[j][3] * v[j][3]); }
    const float rs = 1.0f / sqrtf(wave_sum(s) * (1.0f / D) + EPS);
    GAS v2u* o8 = (GAS v2u*)orow + lane;
#pragma unroll
    for (int j = 0; j < 4; ++j) { const int col = 4 * lane + 256 * j;
        const f32x4 g4 = *(const f32x4*)(g + col), s4 = *(const f32x4*)(sc + col), h4 = *(const f32x4*)(sh + col);
        const f32x4 y = (v[j] * rs) * g4 * (s4 + 1.0f) + h4;
        v2u w; w.x = pk2(y[0], y[1]); w.y = pk2(y[2], y[3]); o8[64 * j] = w; }
}
__device__ __forceinline__ void p0b_phase(const Frame& F, const Args& A) {
    const int gw = blockIdx.x * NWAVES + F.wave, NGW = F.G * NWAVES;
    for (int m = gw; m < M; m += NGW) { const float* md = W_MODS + midx_of(m) * 6144;
        norm_mod_row(xrow_ptr(A.in[I_XP], A.in[I_XS], m), A.in[I_N1G], md + 1024, md, W_XN + (size_t)m * D, F.lane); }
}
__device__ __forceinline__ void p3b_phase(const Frame& F, const Args& A) {
    const int gw = blockIdx.x * NWAVES + F.wave, NGW = F.G * NWAVES;
    for (int m = gw; m < M; m += NGW) { const float* md = W_MODS + midx_of(m) * 6144;
        norm_mod_row(F.out + (size_t)m * D, A.in[I_N2G], md + 4096, md + 3072, W_XN + (size_t)m * D, F.lane); }
}
__device__ __forceinline__ void p6_phase(const Frame& F, const Args& A) {
    const int gw = blockIdx.x * NWAVES + F.wave, NGW = F.G * NWAVES;
    for (int m = gw; m < M; m += NGW) {
        GAS f32x4* xr = (GAS f32x4*)(F.out + (size_t)m * D) + F.lane;
        f32x4 v[4]; float s = 0.f;
#pragma unroll
        for (int j = 0; j < 4; ++j) { v[j] = xr[64 * j]; s += (v[j][0] * v[j][0] + v[j][1] * v[j][1]) + (v[j][2] * v[j][2] + v[j][3] * v[j][3]); }
        const float rs = 1.0f / sqrtf(wave_sum(s) * (1.0f / D) + EPS);
#pragma unroll
        for (int j = 0; j < 4; ++j) { const f32x4 g4 = *(const f32x4*)(A.in[I_FING] + 4 * F.lane + 256 * j); xr[64 * j] = (v[j] * rs) * g4; }
    }
}

struct EpiQKV {
    static constexpr bool PERM = true, AFTER_DRAIN = false;
    bf16* QH; float* state_k;
    __device__ __forceinline__ void operator()(const pg8::f32x4 (&acc)[2][2][4][2], const pg8::Unit& u, int wr, int wc, int fr, int fq) const {
        const int which = u.pn >> 1; const float sc = which == 0 ? C2 : 1.0f;
        bf16* dstb = QH + (size_t)which * ((size_t)NH * M * DH);
        float* st = state_k + (size_t)(which == 2 ? 1 : 0) * ((size_t)32 * NH * LC * DH);
#pragma unroll
        for (int ai = 0; ai < 2; ++ai)
#pragma unroll
            for (int m = 0; m < 4; ++m) { const int row = u.pm * 256 + ai * 128 + wr * 64 + m * 16 + fr;
#pragma unroll
                for (int bj = 0; bj < 2; ++bj) { const int hc = (u.pn & 1) * 256 + bj * 128 + wc * 32 + 8 * fq, h = hc >> 6, d = hc & 63;
                    const f32x4 v0 = acc[ai][bj][m][0] * sc, v1 = acc[ai][bj][m][1] * sc;
                    v4u w; w.x = pk2(v0[0], v0[1]); w.y = pk2(v0[2], v0[3]); w.z = pk2(v1[0], v1[1]); w.w = pk2(v1[2], v1[3]);
                    *(GAS v4u*)(dstb + ((size_t)h * M + row) * DH + d) = w;
                    if (which != 0 && row < MC) { float* sp = st + ((size_t)((row >> 8) * NH + h) * LC + (row & 255)) * DH + d;
                        *(GAS f32x4*)sp = v0; *(GAS f32x4*)(sp + 4) = v1; } } }
    }
};
struct EpiBf16Plain {
    static constexpr bool PERM = true, AFTER_DRAIN = false;
    bf16* O; int ldc;
    __device__ __forceinline__ void operator()(const pg8::f32x4 (&acc)[2][2][4][2], const pg8::Unit& u, int wr, int wc, int fr, int fq) const {
#pragma unroll
        for (int ai = 0; ai < 2; ++ai)
#pragma unroll
            for (int m = 0; m < 4; ++m) { bf16* rowp = O + (size_t)(u.pm * 256 + ai * 128 + wr * 64 + m * 16 + fr) * ldc + u.pn * 256 + wc * 32 + 8 * fq;
#pragma unroll
                for (int bj = 0; bj < 2; ++bj) { const f32x4 v0 = acc[ai][bj][m][0], v1 = acc[ai][bj][m][1];
                    v4u w; w.x = pk2(v0[0], v0[1]); w.y = pk2(v0[2], v0[3]); w.z = pk2(v1[0], v1[1]); w.w = pk2(v1[2], v1[3]);
                    *(GAS v4u*)(rowp + bj * 128) = w; } }
    }
};
struct EpiGatedRes {
    static constexpr bool PERM = false, AFTER_DRAIN = false;
    const float* xp; const float* xs; float* out; const float* gate;
    __device__ __forceinline__ void operator()(const pg8::f32x4 (&acc)[2][2][4][2], const pg8::Unit& u, int wr, int wc, int fr, int fq) const {
        const int row00 = u.pm * 256; const float* gt = gate + midx_of(row00) * 6144;
        const int col0 = u.pn * 256 + wc * 32 + 4 * fq;
        f32x4 gv[2][2];
#pragma unroll
        for (int bj = 0; bj < 2; ++bj)
#pragma unroll
            for (int n = 0; n < 2; ++n) gv[bj][n] = *(const f32x4*)(gt + col0 + bj * 128 + n * 16);
#pragma unroll
        for (int ai = 0; ai < 2; ++ai)
#pragma unroll
            for (int m = 0; m < 4; ++m) { const int row = row00 + ai * 128 + wr * 64 + m * 16 + fr;
                const float* bp = xp ? (row < MC ? xp + (size_t)row * D : xs + (size_t)(row - MC) * D) : out + (size_t)row * D;
                float* op = out + (size_t)row * D;
#pragma unroll
                for (int bj = 0; bj < 2; ++bj)
#pragma unroll
                    for (int n = 0; n < 2; ++n) { const int c = col0 + bj * 128 + n * 16; const f32x4 bs = *(const GAS f32x4*)(bp + c);
                        *(GAS f32x4*)(op + c) = bs + gv[bj][n] * acc[ai][bj][m][n]; }
                if (m & 1) asm volatile("" ::: "memory"); }
    }
};

__device__ __forceinline__ s16x4 vtr(const LAS unsigned char* p) { typedef short v4i16_t __attribute__((ext_vector_type(4)));
    return __builtin_bit_cast(s16x4, __builtin_amdgcn_ds_read_tr16_b64_v4i16((LAS v4i16_t*)p)); }
__device__ __forceinline__ float swap_max(float m) { auto rr = __builtin_amdgcn_permlane32_swap(__float_as_uint(m), __float_as_uint(m), false, false); return fmaxf(__uint_as_float(rr[0]), __uint_as_float(rr[1])); }
__device__ __forceinline__ float swap_sum(float m) { auto rr = __builtin_amdgcn_permlane32_swap(__float_as_uint(m), __float_as_uint(m), false, false); return __uint_as_float(rr[0]) + __uint_as_float(rr[1]); }
template <bool LAT>
__device__ __forceinline__ void attn_item(const Frame& F, const Args& A, int it) {
    const int lane = F.lane, r32 = lane & 31, hi = lane >> 5;
    int h, b, m0, r = 0, rs = 0, qcol = 0;
    if (LAT) { const int half = it & 1; r = (it >> 1) & 15; h = (it >> 5) & 7; b = it >> 8; m0 = MC + b * LL + r * 64 + half * 32; qcol = half * 32 + r32; rs = r - 4; rs = rs < 0 ? 0 : (rs > 8 ? 8 : rs); }
    else { const int qb = it & 7, bh = it >> 3; b = bh >> 3; h = bh & 7; m0 = b * LC + qb * 32; }
    const bf16* Qw = W_QH + ((size_t)h * M + m0) * DH;
    bf16x8 qr[4];
#pragma unroll
    for (int d0 = 0; d0 < 4; ++d0) qr[d0] = *(const GAS bf16x8*)(Qw + r32 * DH + d0 * 16 + hi * 8);
    float m_run = -1e30f, l_run = 0.f; f32x16 o0, o1;
#pragma unroll
    for (int i = 0; i < 16; ++i) { o0[i] = 0.f; o1[i] = 0.f; }
    LAS unsigned char* vimg = F.wl; LAS float* wsf = (LAS float*)(F.wl + 8192);
    const LAS unsigned char* vp = vimg + ((lane >> 4) & 1) * 32 + (lane & 3) * 8 + (4 * hi + ((lane & 15) >> 2)) * 64;
    constexpr int NT = LAT ? 12 : 4;
    for (int t = 0; t < NT; ++t) {
        const bf16 *Kt, *Vt;
        if (LAT && t >= 8) { const size_t row = (size_t)(b * NH + h) * 256 + (t - 8) * 64; Kt = W_CK + row * DH; Vt = W_CV + row * DH; }
        else { const size_t row = (size_t)h * M + (LAT ? (MC + b * LL + (rs + t) * 64) : (b * LC + t * 64)); Kt = W_KH + row * DH; Vt = W_VH + row * DH; }
        bf16x8 kf[8];
#pragma unroll
        for (int d0 = 0; d0 < 4; ++d0)
#pragma unroll
            for (int p = 0; p < 2; ++p) kf[2 * d0 + p] = *(const GAS bf16x8*)(Kt + (r32 + 32 * p) * DH + 16 * d0 + 8 * hi);
        v4u vr[8];
#pragma unroll
        for (int pc = 0; pc < 8; ++pc) vr[pc] = *(const GAS v4u*)(Vt + ((pc & 3) * 16 + (lane >> 2)) * DH + (pc >> 2) * 32 + (lane & 3) * 8);
        f32x16 p0, p1;
#pragma unroll
        for (int i = 0; i < 16; ++i) { p0[i] = 0.f; p1[i] = 0.f; }
#pragma unroll
        for (int d0 = 0; d0 < 4; ++d0) { p0 = __builtin_amdgcn_mfma_f32_32x32x16_bf16(kf[2 * d0], qr[d0], p0, 0, 0, 0); p1 = __builtin_amdgcn_mfma_f32_32x32x16_bf16(kf[2 * d0 + 1], qr[d0], p1, 0, 0, 0); }
        if (LAT && t < 8) {
            const float* bt = W_BT + ((size_t)(h * 15 + (rs + t - r + 7)) * 64 + qcol) * 64 + 4 * hi;
#pragma unroll
            for (int a = 0; a < 4; ++a) { const f32x4 b0 = *(const GAS f32x4*)(bt + 8 * a), b1 = *(const GAS f32x4*)(bt + 32 + 8 * a);
#pragma unroll
                for (int c = 0; c < 4; ++c) { p0[4 * a + c] += b0[c]; p1[4 * a + c] += b1[c]; } }
        }
#pragma unroll
        for (int pc = 0; pc < 8; ++pc) *(LAS v4u*)(vimg + pc * 1024 + lane * 16) = vr[pc];
        float rm = fmaxf(p0[0], p1[0]);
#pragma unroll
        for (int i = 1; i < 16; ++i) rm = fmaxf(rm, fmaxf(p0[i], p1[i]));
        rm = swap_max(rm);
        const float mn = fmaxf(m_run, rm), alpha = __builtin_amdgcn_exp2f(m_run - mn); m_run = mn;
        float ls = 0.f;
#pragma unroll
        for (int i = 0; i < 16; ++i) { p0[i] = __builtin_amdgcn_exp2f(p0[i] - mn); p1[i] = __builtin_amdgcn_exp2f(p1[i] - mn); ls += p0[i] + p1[i]; }
        l_run = l_run * alpha + ls;
        if (hi == 0) wsf[r32] = alpha;
#pragma unroll
        for (int a = 0; a < 4; ++a) { const f32x4 al = *(const LAS f32x4*)(wsf + 8 * a + 4 * hi);
#pragma unroll
            for (int c = 0; c < 4; ++c) { o0[4 * a + c] *= al[c]; o1[4 * a + c] *= al[c]; } }
        v4u pw[4];
        pw[0] = (v4u){pk2(p0[0], p0[1]), pk2(p0[2], p0[3]), pk2(p0[4], p0[5]), pk2(p0[6], p0[7])};
        pw[1] = (v4u){pk2(p0[8], p0[9]), pk2(p0[10], p0[11]), pk2(p0[12], p0[13]), pk2(p0[14], p0[15])};
        pw[2] = (v4u){pk2(p1[0], p1[1]), pk2(p1[2], p1[3]), pk2(p1[4], p1[5]), pk2(p1[6], p1[7])};
        pw[3] = (v4u){pk2(p1[8], p1[9]), pk2(p1[10], p1[11]), pk2(p1[12], p1[13]), pk2(p1[14], p1[15])};
#pragma unroll
        for (int ks = 0; ks < 4; ++ks) {
            const s16x4 l0 = vtr(vp + ks * 1024), h0 = vtr(vp + ks * 1024 + 512), l1 = vtr(vp + 4096 + ks * 1024), h1 = vtr(vp + 4096 + ks * 1024 + 512);
            const bf16x8 v0 = (bf16x8){l0[0], l0[1], l0[2], l0[3], h0[0], h0[1], h0[2], h0[3]}, v1 = (bf16x8){l1[0], l1[1], l1[2], l1[3], h1[0], h1[1], h1[2], h1[3]};
            const bf16x8 pa = __builtin_bit_cast(bf16x8, pw[ks]);
            o0 = __builtin_amdgcn_mfma_f32_32x32x16_bf16(pa, v0, o0, 0, 0, 0);
            o1 = __builtin_amdgcn_mfma_f32_32x32x16_bf16(pa, v1, o1, 0, 0, 0);
        }
    }
    const float lt = swap_sum(l_run);
    if (hi == 0) wsf[32 + r32] = 1.0f / lt;
    bf16* Ow = W_AO + (size_t)m0 * D + h * DH + r32;
#pragma unroll
    for (int a = 0; a < 4; ++a) { const f32x4 rl = *(const LAS f32x4*)(wsf + 32 + 8 * a + 4 * hi);
#pragma unroll
        for (int c = 0; c < 4; ++c) { const int q = c + 8 * a + 4 * hi;
            Ow[(size_t)q * D] = f2bf(o0[4 * a + c] * rl[c]); Ow[(size_t)q * D + 32] = f2bf(o1[4 * a + c] * rl[c]); } }
    LDS_WAIT(); asm volatile("" ::: "memory");
}

__device__ __forceinline__ f32x4 conv3_4(const bf16* row, int t, int L, float w0, float w1, float w2, float bias) {
    const v2u x = *(const GAS v2u*)(row + t);
    const float xm = t > 0 ? bf1(row[t - 1]) : 0.f, xp = (t + 4 < L) ? bf1(row[t + 4]) : 0.f;
    const float x0 = bflo(x.x), x1 = bfhi(x.x), x2 = bflo(x.y), x3 = bfhi(x.y);
    return (f32x4){w0 * xm + w1 * x0 + w2 * x1 + bias, w0 * x0 + w1 * x1 + w2 * x2 + bias, w0 * x1 + w1 * x2 + w2 * x3 + bias, w0 * x2 + w1 * x3 + w2 * xp + bias};
}
template <int L>
__device__ __forceinline__ void hyena_item(const Frame& F, const Args& A, int c, int m_base) {
    constexpr int TL = 2 * L + 128, LU = L + 112, MT = L / 64, J = (L + 48 + 31) / 32;
    const bf16* KR = (L == LL) ? W_KRL : W_KRC;
    LAS unsigned char* FE = F.wl; LAS unsigned char* UB = F.wl + 4 * TL;
    const int lane = F.lane, i16 = lane & 15, g = lane >> 4, a = i16 >> 2, b = i16 & 3;
    if (lane < 56) { const int row = lane / 14, k = lane % 14, off = k < 6 ? k * 8 : 48 + L + (k - 6) * 8; *(LAS v4u*)(UB + (row * LU + off) * 2) = (v4u){0u, 0u, 0u, 0u}; }
    { const int ch = 1024 + c; const float w0 = A.in[I_HCW][ch], w1 = A.in[I_HCW][HYC + ch], w2 = A.in[I_HCW][2 * HYC + ch], bs = A.in[I_HCB][ch];
      const bf16* vrow = W_HYT + (size_t)ch * M + m_base;
      for (int idx = lane; idx < 4 * L / 8; idx += 64) { const int bb = idx / (L / 8), s = (idx % (L / 8)) * 8; const bf16* src = vrow + bb * L + s;
          const v4u x = *(const GAS v4u*)src; const float xm = s > 0 ? bf1(src[-1]) : 0.f, xp = (s + 8 < L) ? bf1(src[8]) : 0.f;
          float e[10]; e[0] = xm; e[1] = bflo(x.x); e[2] = bfhi(x.x); e[3] = bflo(x.y); e[4] = bfhi(x.y); e[5] = bflo(x.z); e[6] = bfhi(x.z); e[7] = bflo(x.w); e[8] = bfhi(x.w); e[9] = xp;
          float o[8];
#pragma unroll
          for (int k = 0; k < 8; ++k) o[k] = w0 * e[k] + w1 * e[k + 1] + w2 * e[k + 2] + bs;
          *(LAS v4u*)(UB + (bb * LU + 48 + s) * 2) = (v4u){pk2(o[0], o[1]), pk2(o[2], o[3]), pk2(o[4], o[5]), pk2(o[6], o[7])}; } }
    const int x0 = 8 * g - i16 + L + 16;
    const LAS unsigned char* pA = (i16 & 1) ? FE + 2 * TL + 2 * (x0 + 1) : FE + 2 * x0;
    const LAS unsigned char* pB = UB + (b * LU + 16 * a + 8 * g) * 2;
#pragma unroll 1
    for (int order = 0; order < 2; ++order) {
        { const bf16* src = KR + (size_t)((order * 512 + c) * 2) * TL;
          for (int idx = lane; idx < TL / 4; idx += 64) *(LAS v4u*)(FE + idx * 16) = *(const GAS v4u*)(src + idx * 8); }
        f32x4 acc[MT];
#pragma unroll
        for (int mt = 0; mt < MT; ++mt) acc[mt] = (f32x4){0.f, 0.f, 0.f, 0.f};
#pragma unroll 1
        for (int e = -(2 * (MT - 1)); e <= J - 1; ++e) {
            const LAS unsigned* ap = (const LAS unsigned*)(pA + 64 * e);
            const v4u af = (v4u){ap[0], ap[1], ap[2], ap[3]};
            const bf16x8 afr = __builtin_bit_cast(bf16x8, af);
#pragma unroll
            for (int mt = 0; mt < MT; ++mt) { const int j = e + 2 * mt;
                if (j >= 0 && j < J) { const bf16x8 bfr = *(const LAS bf16x8*)(pB + 64 * j);
                    acc[mt] = __builtin_amdgcn_mfma_f32_16x16x32_bf16(afr, bfr, acc[mt], 0, 0, 0); } }
        }
        const int ch = order == 0 ? c : 512 + c;
        const float w0 = A.in[I_HCW][ch], w1 = A.in[I_HCW][HYC + ch], w2 = A.in[I_HCW][2 * HYC + ch], bs = A.in[I_HCB][ch];
        const bf16* xrow = W_HYT + (size_t)ch * M + m_base + b * L;
#pragma unroll
        for (int mt = 0; mt < MT; ++mt) { const int t = 64 * mt + 16 * a + 4 * g;
            const f32x4 xv = conv3_4(xrow, t, L, w0, w1, w2, bs), y = xv * acc[mt];
            const v2u w = (v2u){pk2(y[0], y[1]), pk2(y[2], y[3])};
            if (order == 0) *(LAS v2u*)(UB + (b * LU + 48 + t) * 2) = w;
            else *(GAS v2u*)(W_HYOT + (size_t)c * M + m_base + b * L + t) = w; }
    }
    LDS_WAIT(); asm volatile("" ::: "memory");
}
__device__ __forceinline__ void p2_phase(const Frame& F, const Args& A) {
    LAS unsigned* qc = (LAS unsigned*)(F.lds + MISC_OFF) + 9;
    constexpr int X0 = 1 + (PROBE_P2 & 1), X1 = 1 + ((PROBE_P2 >> 1) & 1), X2 = 1 + ((PROBE_P2 >> 2) & 1), X3 = 1 + ((PROBE_P2 >> 3) & 1);
    constexpr int N_HL = 512 * X0, N_AL = 1024 * X1, N_AC = 2048 * X2, N_HC = 4096 * X3, NI = N_HL + N_AL + N_AC + N_HC;
    for (;;) {
        int it = 0; if (F.lane == 0) it = (int)__hip_atomic_fetch_add(qc, 1u, __ATOMIC_RELAXED, __HIP_MEMORY_SCOPE_WORKGROUP);
        it = __builtin_amdgcn_readfirstlane(it) * F.G + (int)blockIdx.x;
        if (it >= NI) break;
        if (it < N_HL) { hyena_item<LL>(F, A, it & 511, MC); continue; } it -= N_HL;
        if (it < N_AL) { attn_item<true>(F, A, it & 1023); continue; } it -= N_AL;
        if (it < N_AC) { attn_item<false>(F, A, it & 2047); continue; } it -= N_AC;
        it &= 4095; hyena_item<LC>(F, A, it >> 3, (it & 7) * 1024);
    }
}

__device__ __forceinline__ void p2b_phase(const Frame& F, const Args& A) {
    LAS unsigned char* T = F.lds;
    for (int it = blockIdx.x; it < M / 48; it += F.G) {
        const int m0 = it * 48;
#pragma unroll
        for (int k = 0; k < 6; ++k) { const int idx = F.tid + 512 * k, row = idx / 6, ch = idx % 6;
            *(LAS v4u*)(T + row * 96 + ch * 16) = *(const GAS v4u*)(W_HYOT + (size_t)row * M + m0 + ch * 8); }
        __syncthreads();
        for (int tk = F.wave * 6; tk < F.wave * 6 + 6; ++tk) { const int m = m0 + tk; bf16* arow = W_AO + (size_t)m * D;
            { const v4u x = *(const GAS v4u*)(arow + 8 * F.lane);
              float e[8] = {bflo(x.x), bfhi(x.x), bflo(x.y), bfhi(x.y), bflo(x.z), bfhi(x.z), bflo(x.w), bfhi(x.w)}; float s = 0.f;
#pragma unroll
              for (int k = 0; k < 8; ++k) s += e[k] * e[k];
              const float rs = 1.0f / sqrtf(wave_sum(s) * (1.0f / 512.0f) + EPS);
              const f32x4 g0 = *(const f32x4*)(A.in[I_GNG] + 8 * F.lane), g1 = *(const f32x4*)(A.in[I_GNG] + 8 * F.lane + 4);
              *(GAS v4u*)(arow + 8 * F.lane) = (v4u){pk2(e[0] * rs * g0[0], e[1] * rs * g0[1]), pk2(e[2] * rs * g0[2], e[3] * rs * g0[3]), pk2(e[4] * rs * g1[0], e[5] * rs * g1[1]), pk2(e[6] * rs * g1[2], e[7] * rs * g1[3])}; }
            { float e[8]; float s = 0.f;
#pragma unroll
              for (int k = 0; k < 8; ++k) { e[k] = bf1(*(const LAS unsigned short*)(T + (8 * F.lane + k) * 96 + tk * 2)); s += e[k] * e[k]; }
              const float rs = 1.0f / sqrtf(wave_sum(s) * (1.0f / 512.0f) + EPS);
              const f32x4 g0 = *(const f32x4*)(A.in[I_GNG] + 512 + 8 * F.lane), g1 = *(const f32x4*)(A.in[I_GNG] + 512 + 8 * F.lane + 4);
              *(GAS v4u*)(arow + 512 + 8 * F.lane) = (v4u){pk2(e[0] * rs * g0[0], e[1] * rs * g0[1]), pk2(e[2] * rs * g0[2], e[3] * rs * g0[3]), pk2(e[4] * rs * g1[0], e[5] * rs * g1[1]), pk2(e[6] * rs * g1[2], e[7] * rs * g1[3])}; }
        }
        __syncthreads();
    }
}

__device__ __forceinline__ void p4b_ld(const bf16* up, int rr, f32x4& gg, f32x4& vv, bool ok) {
    if (ok) { const v2u a = *(const GAS v2u*)(up + (long)rr * UPC), b2 = *(const GAS v2u*)(up + (long)rr * UPC + DFF);
        gg = (f32x4){bflo(a.x), bfhi(a.x), bflo(a.y), bfhi(a.y)}; vv = (f32x4){bflo(b2.x), bfhi(b2.x), bflo(b2.y), bfhi(b2.y)}; }
    else { gg = (f32x4){0.f, 0.f, 0.f, 0.f}; vv = gg; }
}
__device__ __forceinline__ void p4b_phase(const Frame& F, const Args& A) {
    const int gw = blockIdx.x * NWAVES + F.wave, NGW = F.G * NWAVES, lane = F.lane;
    for (int it = gw; it < (M / 16) * 11; it += NGW) {
        const int rc = it / 11, cb = it % 11, m0 = rc * 16, col = cb * 256 + lane * 4;
        const int L = m0 < MC ? LC : LL, t0 = m0 < MC ? (m0 & (LC - 1)) : ((m0 - MC) & (LL - 1));
        f32x4 gw0 = *(const f32x4*)(A.in[I_FCW] + col), gw1 = *(const f32x4*)(A.in[I_FCW] + UPC + col), gw2 = *(const f32x4*)(A.in[I_FCW] + 2 * UPC + col), gb = *(const f32x4*)(A.in[I_FCB] + col);
        f32x4 uw0 = *(const f32x4*)(A.in[I_FCW] + DFF + col), uw1 = *(const f32x4*)(A.in[I_FCW] + UPC + DFF + col), uw2 = *(const f32x4*)(A.in[I_FCW] + 2 * UPC + DFF + col), ub = *(const f32x4*)(A.in[I_FCB] + DFF + col);
        const bf16* up = W_U + (size_t)m0 * UPC + col;
        f32x4 gp, gc, gn, vp, vc, vn;
        p4b_ld(up, -1, gp, vp, t0 > 0); p4b_ld(up, 0, gc, vc, true);
#pragma unroll 4
        for (int rr = 0; rr < 16; ++rr) {
            p4b_ld(up, rr + 1, gn, vn, t0 + rr + 1 < L);
            const f32x4 G = gw0 * gp + gw1 * gc + gw2 * gn + gb, V = uw0 * vp + uw1 * vc + uw2 * vn + ub;
            float a[4];
#pragma unroll
            for (int k = 0; k < 4; ++k) a[k] = (G[k] / (1.0f + __expf(-G[k]))) * V[k];
            *(GAS v2u*)(W_ACT + (size_t)(m0 + rr) * DFF + col) = (v2u){pk2(a[0], a[1]), pk2(a[2], a[3])};
            gp = gc; gc = gn; vp = vc; vc = vn;
        }
    }
}

constexpr int N_PHASES = 11;
constexpr int N_LAUNCHES = MK_N_LAUNCHES;
__global__ void __launch_bounds__(NWAVES * 64, 2) fwd_kernel(Args args) {
    extern __shared__ __attribute__((aligned(16))) unsigned char lds[];
    const Args& A = args;
    Frame F;
    F.lds = (LAS unsigned char*)lds;
    F.tid = threadIdx.x; F.lane = F.tid & 63; F.wave = __builtin_amdgcn_readfirstlane(F.tid >> 6); F.G = gridDim.x;
    F.wl = F.lds + F.wave * WAVE_LDS;
    F.ws = args.ws; F.out = args.out;
    volatile LAS unsigned* MISC = (volatile LAS unsigned*)(F.lds + MISC_OFF);
    if (F.tid < 16) MISC[F.tid] = 0u;
    __syncthreads();
    XcdBarrier bar; bar.bar = (unsigned*)(W_CTL + CW_BAR); bar.x = 0; bar.st = nullptr;
    if (N_LAUNCHES == 1) bar = xcd_barrier_post((unsigned*)(W_CTL + CW_BAR), MISC);
    const int lo = args.ph_lo, hi = args.ph_hi;
#define IN(k) (lo <= (k) && (k) < hi)
#define SEAM(k) do { if (IN(k) && IN((k) + 1)) xcd_barrier(bar); } while (0)
    if (IN(0)) { p0a_phase(F, A); } SEAM(0);
    if (IN(1)) { p0b_phase(F, A); } SEAM(1);
    if (IN(2)) {
        { pg8::Gemm g{W_XN, W_WIN, M, QKVC, D}; pg8::StaticOrder S; S.init(M, QKVC, F.G, (int)blockIdx.x);
          EpiQKV E{W_QH, F.out + (size_t)M * D};
          pg8::gemm_phase<EpiQKV, pg8::StaticOrder, true, true>(F.lds, g, S, E); }
        { pg8::Gemm g{W_WIN + (size_t)QKVC * D, W_XN, HYC, M, D}; pg8::StaticOrder S; S.init(HYC, M, F.G, (int)(F.G - 1 - blockIdx.x));
          EpiBf16Plain E{W_HYT, M};
          pg8::gemm_phase<EpiBf16Plain, pg8::StaticOrder, true, true>(F.lds, g, S, E); }
    } SEAM(2);
    if (IN(3)) { p2_phase(F, A); } SEAM(3);
    if (IN(4)) { p2b_phase(F, A); } SEAM(4);
    if (IN(5)) {
        pg8::Gemm g{W_AO, W_WOUT, M, D, D}; pg8::StaticOrder S; S.init(M, D, F.G, (int)blockIdx.x);
        EpiGatedRes E{A.in[I_XP], A.in[I_XS], F.out, W_MODS + 2048};
        pg8::gemm_phase<EpiGatedRes, pg8::StaticOrder, true, true>(F.lds, g, S, E);
    } SEAM(5);
    if (IN(6)) { p3b_phase(F, A); } SEAM(6);
    if (IN(7)) {
        pg8::Gemm g{W_XN, W_WUP, M, UPC, D}; pg8::StaticOrder S; S.init(M, UPC, F.G, (int)blockIdx.x);
        EpiBf16Plain E{W_U, UPC};
        pg8::gemm_phase<EpiBf16Plain, pg8::StaticOrder, true, true>(F.lds, g, S, E);
    } SEAM(7);
    if (IN(8)) { p4b_phase(F, A); } SEAM(8);
    if (IN(9)) {
        pg8::Gemm g{W_ACT, W_WDN, M, D, DFF}; pg8::StaticOrder S; S.init(M, D, F.G, (int)blockIdx.x);
        EpiGatedRes E{nullptr, nullptr, F.out, W_MODS + 5120};
        pg8::gemm_phase<EpiGatedRes, pg8::StaticOrder, true, true>(F.lds, g, S, E);
    } SEAM(9);
    if (IN(10)) { p6_phase(F, A); }
#undef IN
#undef SEAM
}

extern "C" void kernel_launch(void* const* d_in, const int* in_sizes, int n_in, void* d_out, int out_size, void* d_ws, size_t ws_size, hipStream_t stream) {
    static int grid = 0;
    if (grid == 0) {
        if (n_in != 29 || ws_size < WS_END) { fprintf(stderr, "kernel_launch: expected 29 inputs and >= %zu bytes of workspace (got %d, %zu)\n", (size_t)WS_END, n_in, ws_size); grid = -1; return; }
        int dev = 0, cus = 0, per_cu = 0;
        if (hipGetDevice(&dev) != hipSuccess || hipDeviceGetAttribute(&cus, hipDeviceAttributeMultiprocessorCount, dev) != hipSuccess) { grid = -1; return; }
        if (hipFuncSetAttribute((const void*)fwd_kernel, hipFuncAttributeMaxDynamicSharedMemorySize, LDS_BYTES) != hipSuccess) { fprintf(stderr, "kernel_launch: hipFuncSetAttribute failed\n"); grid = -1; return; }
        if (hipOccupancyMaxActiveBlocksPerMultiprocessor(&per_cu, (const void*)fwd_kernel, NWAVES * 64, LDS_BYTES) != hipSuccess || per_cu < 1) { fprintf(stderr, "kernel_launch: occupancy query says %d\n", per_cu); per_cu = 1; }
        (void)hipGetLastError();
        grid = cus * (per_cu > 1 ? 1 : per_cu);
    }
    if (grid < 0) return;
    (void)hipMemsetAsync((char*)d_ws + WS_CTL, 0, CTL_ZERO_BYTES, stream);
    Args a{};
    for (int i = 0; i < 29; ++i) a.in[i] = (const float*)d_in[i];
    a.out = (float*)d_out; a.ws = (unsigned char*)d_ws;
    if (N_LAUNCHES == 1) { a.ph_lo = 0; a.ph_hi = N_PHASES; hipLaunchKernelGGL(fwd_kernel, dim3(grid), dim3(NWAVES * 64), LDS_BYTES, stream, a); }
    else for (int li = 0; li < N_PHASES; ++li) for (int rep = 0; rep < 1 + ((PROBE_DUP >> li) & 1); ++rep) { a.ph_lo = li; a.ph_hi = li + 1; a.qsel = rep; hipLaunchKernelGGL(fwd_kernel, dim3(grid), dim3(NWAVES * 64), LDS_BYTES, stream, a); }
    const hipError_t le = hipPeekAtLastError();
    if (le != hipSuccess) fprintf(stderr, "kernel_launch: launch failed: %s\n", hipGetErrorName(le));
}
```
